# Optimizing an MI355X kernel written in HIP

```python
import math
import jax, jax.numpy as jnp
from jax import lax
import numpy as np

D_MODEL = 1024
BATCH = 32
SEQ = 2048
DEPTH = 2

GRID_W = 64
CTX_LEN = 256
HEAD_DIM = 64
A_HEADS = D_MODEL // (2 * HEAD_DIM)
A_WIDTH = A_HEADS * 2 * HEAD_DIM
A_IN_WIDTH = 4 * A_WIDTH
B_HEADS = D_MODEL // HEAD_DIM
B_KV_HEADS = 4
B_GROUP = B_HEADS // B_KV_HEADS
B_WIDTH = B_HEADS * HEAD_DIM
B_KV_WIDTH = B_KV_HEADS * HEAD_DIM
B_IN_WIDTH = 2 * B_WIDTH + 2 * B_KV_WIDTH
MIX_WIDTH = A_WIDTH
WINDOW = 128
Q_BLOCK = 128
BAND = Q_BLOCK + 2 * WINDOW
ROPE_THETA = 10000.0
NORM_EPS = 1e-6
SUBLN_EPS = 1e-5
NEG_INF = -1e30
ATTN_SCALE = HEAD_DIM ** -0.5
N_A_LAYERS = (DEPTH + 1) // 2
N_B_LAYERS = DEPTH // 2

kernel_name = 'hybrid_diffattn_windowgqa_ctxprefix_dit'


def rms_norm(x, g, eps=NORM_EPS):
    x32 = x.astype(jnp.float32)
    y = x32 * lax.rsqrt(jnp.mean(x32 * x32, axis=-1, keepdims=True) + eps)
    return (y * g.astype(jnp.float32)).astype(x.dtype)


def modulate(h, shift, scale):
    return h * (1.0 + scale) + shift


def axial_angles(rows, rot_dim=HEAD_DIM):
    row = jnp.repeat(jnp.arange(rows, dtype=jnp.int32), GRID_W).astype(jnp.float32)
    col = jnp.tile(jnp.arange(GRID_W, dtype=jnp.int32), rows).astype(jnp.float32)
    axis_dim = rot_dim // 2
    inv_freq = ROPE_THETA ** (-jnp.arange(0, axis_dim, 2, dtype=jnp.float32) / axis_dim)
    return row[:, None] * inv_freq, col[:, None] * inv_freq


def rope_1d(x, ang):
    ang = ang.reshape(ang.shape[:1] + (1,) * (x.ndim - 3) + ang.shape[1:])
    cos, sin = jnp.cos(ang), jnp.sin(ang)
    x1, x2 = jnp.split(x.astype(jnp.float32), 2, axis=-1)
    return jnp.concatenate([x1 * cos - x2 * sin, x2 * cos + x1 * sin], axis=-1).astype(x.dtype)


def rope_axial(x, ang_r, ang_c):
    xr, xc = jnp.split(x, 2, axis=-1)
    return jnp.concatenate([rope_1d(xr, ang_r), rope_1d(xc, ang_c)], axis=-1)


def diff_attention_mixer(hx, hc, w_in, lq1, lk1, lq2, lk2, subln_g, layer_idx, with_ctx_out, ang_r, ang_c):
    B, S, _ = hx.shape
    nblk = S // Q_BLOCK
    lam_init = 0.8 - 0.6 * math.exp(-0.3 * layer_idx)
    f32 = jnp.float32
    lam = (jnp.exp(jnp.sum(lq1.astype(f32) * lk1.astype(f32)))
           - jnp.exp(jnp.sum(lq2.astype(f32) * lk2.astype(f32))) + lam_init)

    def split(p):
        q, k, v, g = jnp.split(p, [A_WIDTH, 2 * A_WIDTH, 3 * A_WIDTH], axis=-1)
        lead = p.shape[:2]
        return (q.reshape(lead + (A_HEADS, 2, HEAD_DIM)),
                k.reshape(lead + (A_HEADS, 2, HEAD_DIM)),
                v.reshape(lead + (A_HEADS, 2 * HEAD_DIM)), g)

    qx, kx, vx, gx = split(hx @ w_in)
    qc, kc, vc, gc = split(hc @ w_in)
    qx = rope_axial(qx, ang_r, ang_c)
    kx = rope_axial(kx, ang_r, ang_c)
    k_all = jnp.concatenate([kc, kx], axis=1)
    v_all = jnp.concatenate([vc, vx], axis=1)

    def attend(qb, keys, vals):
        s = jnp.einsum('bqhmd,bkhmd->bhmqk', qb, keys).astype(f32) * ATTN_SCALE
        p = jax.nn.softmax(s, axis=-1)
        a = p[:, :, 0] - lam * p[:, :, 1]
        return jnp.einsum('bhqk,bkhe->bqhe', a.astype(vals.dtype), vals)

    q_blocks = qx.reshape(B, nblk, Q_BLOCK, A_HEADS, 2, HEAD_DIM).swapaxes(0, 1)
    ox = lax.map(lambda qb: attend(qb, k_all, v_all), q_blocks)
    ox = ox.swapaxes(0, 1).reshape(B, S, A_HEADS, 2 * HEAD_DIM)

    def finish(o, g):
        o = rms_norm(o, subln_g, SUBLN_EPS) * (1.0 - lam_init)
        return o.reshape(o.shape[:2] + (A_WIDTH,)) * jax.nn.silu(g)

    out_x = finish(ox, gx)
    out_c = finish(attend(qc, kc, vc), gc) if with_ctx_out else None
    return out_x, out_c


def window_gqa_mixer(hx, hc, w_in, sink, with_ctx_out, ang_r, ang_c):
    B, S, _ = hx.shape
    nblk = S // Q_BLOCK
    f32 = jnp.float32

    def split(p):
        q, k, v, g = jnp.split(p, [B_WIDTH, B_WIDTH + B_KV_WIDTH, B_WIDTH + 2 * B_KV_WIDTH], axis=-1)
        lead = p.shape[:2]
        return (q.reshape(lead + (B_KV_HEADS, B_GROUP, HEAD_DIM)),
                k.reshape(lead + (B_KV_HEADS, HEAD_DIM)),
                v.reshape(lead + (B_KV_HEADS, HEAD_DIM)), g)

    qx, kx, vx, gx = split(hx @ w_in)
    qc, kc, vc, gc = split(hc @ w_in)
    qx = rope_axial(qx, ang_r, ang_c)
    kx = rope_axial(kx, ang_r, ang_c)
    n_ctx = kc.shape[1]
    sink_f = sink.astype(f32).reshape(B_KV_HEADS, B_GROUP)[None, :, :, None, None]

    def sink_softmax(s):
        sb = jnp.broadcast_to(sink_f, s.shape[:-1] + (1,))
        return jax.nn.softmax(jnp.concatenate([s, sb], axis=-1), axis=-1)[..., :-1]

    pad = ((0, 0), (WINDOW, WINDOW), (0, 0), (0, 0))
    kp = jnp.pad(kx, pad)
    vp = jnp.pad(vx, pad)
    q_blocks = qx.reshape(B, nblk, Q_BLOCK, B_KV_HEADS, B_GROUP, HEAD_DIM).swapaxes(0, 1)

    def block(args):
        qb, i = args
        start = i * Q_BLOCK
        kb = lax.dynamic_slice_in_dim(kp, start, BAND, axis=1)
        vb = lax.dynamic_slice_in_dim(vp, start, BAND, axis=1)
        qpos = start + jnp.arange(Q_BLOCK)
        kpos = start - WINDOW + jnp.arange(BAND)
        mask = ((jnp.abs(qpos[:, None] - kpos[None, :]) <= WINDOW)
                & (kpos >= 0)[None, :] & (kpos < S)[None, :])
        s_band = jnp.einsum('bqhgd,bjhd->bhgqj', qb, kb).astype(f32) * ATTN_SCALE
        s_band = jnp.where(mask, s_band, NEG_INF)
        s_ctx = jnp.einsum('bqhgd,bjhd->bhgqj', qb, kc).astype(f32) * ATTN_SCALE
        p = sink_softmax(jnp.concatenate([s_ctx, s_band], axis=-1)).astype(vb.dtype)
        return (jnp.einsum('bhgqj,bjhd->bqhgd', p[..., :n_ctx], vc)
                + jnp.einsum('bhgqj,bjhd->bqhgd', p[..., n_ctx:], vb))

    ox = lax.map(block, (q_blocks, jnp.arange(nblk)))
    out_x = ox.swapaxes(0, 1).reshape(B, S, B_WIDTH) * jax.nn.silu(gx)
    out_c = None
    if with_ctx_out:
        s = jnp.einsum('bqhgd,bjhd->bhgqj', qc, kc).astype(f32) * ATTN_SCALE
        p = sink_softmax(s).astype(vc.dtype)
        oc = jnp.einsum('bhgqj,bjhd->bqhgd', p, vc)
        out_c = oc.reshape(oc.shape[:2] + (B_WIDTH,)) * jax.nn.silu(gc)
    return out_x, out_c


def setup_inputs(seed: int = 0) -> dict:
    key = jax.random.key(seed)
    ks = jax.random.split(key, 17)
    nrm = jax.random.normal
    f32 = jnp.float32
    return {
        'x': nrm(ks[0], (BATCH, SEQ, D_MODEL), f32),
        'c': nrm(ks[1], (BATCH, D_MODEL), f32),
        'ctx': nrm(ks[2], (BATCH, CTX_LEN, D_MODEL), f32),
        'c_ctx': nrm(ks[3], (D_MODEL,), f32),
        'w_mod': nrm(ks[4], (DEPTH, D_MODEL, 3 * D_MODEL), f32) * D_MODEL ** -0.5,
        'b_mod': 0.01 * nrm(ks[5], (DEPTH, 3 * D_MODEL), f32),
        'norm_g': 1.0 + 0.02 * nrm(ks[6], (DEPTH, D_MODEL), f32),
        'w_o': nrm(ks[7], (DEPTH, MIX_WIDTH, D_MODEL), f32) * MIX_WIDTH ** -0.5,
        'a_w_in': nrm(ks[8], (N_A_LAYERS, D_MODEL, A_IN_WIDTH), f32) * D_MODEL ** -0.5,
        'a_lambda_q1': 0.1 * nrm(ks[9], (N_A_LAYERS, HEAD_DIM), f32),
        'a_lambda_k1': 0.1 * nrm(ks[10], (N_A_LAYERS, HEAD_DIM), f32),
        'a_lambda_q2': 0.1 * nrm(ks[11], (N_A_LAYERS, HEAD_DIM), f32),
        'a_lambda_k2': 0.1 * nrm(ks[12], (N_A_LAYERS, HEAD_DIM), f32),
        'a_subln_g': 1.0 + 0.02 * nrm(ks[13], (N_A_LAYERS, 2 * HEAD_DIM), f32),
        'b_w_in': nrm(ks[14], (N_B_LAYERS, D_MODEL, B_IN_WIDTH), f32) * D_MODEL ** -0.5,
        'b_sink': 0.5 * nrm(ks[15], (N_B_LAYERS, B_HEADS), f32),
        'final_g': 1.0 + 0.02 * nrm(ks[16], (D_MODEL,), f32),
    }


def reference(x, c, ctx, c_ctx, w_mod, b_mod, norm_g, w_o, a_w_in, a_lambda_q1, a_lambda_k1,
              a_lambda_q2, a_lambda_k2, a_subln_g, b_w_in, b_sink, final_g):
    n_tokens = x.shape[1]
    rows = n_tokens // GRID_W
    ang_r, ang_c = axial_angles(rows)
    sc = jax.nn.silu(c)
    sctx = jax.nn.silu(c_ctx)
    for i in range(DEPTH):
        last = i == DEPTH - 1
        shift_x, scale_x, gate_x = jnp.split(sc @ w_mod[i] + b_mod[i], 3, axis=-1)
        shift_c, scale_c, gate_c = jnp.split(sctx @ w_mod[i] + b_mod[i], 3, axis=-1)
        hx = modulate(rms_norm(x, norm_g[i]), shift_x[:, None], scale_x[:, None])
        hc = modulate(rms_norm(ctx, norm_g[i]), shift_c, scale_c)
        j = i // 2
        if i % 2 == 0:
            ox, oc = diff_attention_mixer(hx, hc, a_w_in[j], a_lambda_q1[j], a_lambda_k1[j],
                                          a_lambda_q2[j], a_lambda_k2[j], a_subln_g[j], i,
                                          not last, ang_r, ang_c)
        else:
            ox, oc = window_gqa_mixer(hx, hc, b_w_in[j], b_sink[j], not last, ang_r, ang_c)
        x = x + gate_x[:, None] * (ox @ w_o[i])
        if not last:
            ctx = ctx + gate_c * (oc @ w_o[i])
    return rms_norm(x, final_g)
```

```cpp
#include <hip/hip_runtime.h>
#include <hip/hip_cooperative_groups.h>
#include <cstdio>
#include <cstdint>
namespace cg = cooperative_groups;
namespace pg8 {
#define PG8_LAS __attribute__((address_space(3)))
typedef unsigned short bf16_t;
typedef short bf16x8 __attribute__((ext_vector_type(8)));
typedef float f32x4 __attribute__((ext_vector_type(4)));
typedef unsigned u32x4 __attribute__((ext_vector_type(4)));
constexpr int BM = 256, BK = 64, HALF = 128, HTB = HALF * BK * 2  , STAGE_BYTES = 8 * HTB, NXCD = 8, WGM = 8;

__host__ __device__ __forceinline__ int lds_byte(int r, int c) { const int st = (r >> 4) * 2 + (c >> 5), rr = r & 15, cc = c & 31, ob = rr * 64 + cc * 2; return st * 1024 + (ob ^ (((ob >> 9) & 1) << 5)); }
__host__ __device__ __forceinline__ void stage_rc(int b, int& R, int& C) { const int st = b / 1024, sb = b % 1024, swz = sb ^ (((sb >> 9) & 1) << 5); R = (st >> 1) * 16 + swz / 64; C = (st & 1) * 32 + (swz % 64) / 2; }
__host__ __device__ __forceinline__ int perm32(int rho) { const int n = rho >> 4, i = rho & 15; return 8 * (i >> 2) + 4 * n + (i & 3); }

struct Unit { int pm, pn; };
struct Gemm { const bf16_t* A; const bf16_t* Bt; int M, N, K; };

struct StaticOrder {
    int nM, nN, nwg, G, c;
    __host__ __device__ void init(int M, int N, int G_, int c_) { nM = M / BM; nN = N / BM; nwg = nM * nN; G = G_; c = c_; }
    __host__ __device__ bool next(int i, Unit& u) const {
        const long L = (long)i * G + c; if (L >= nwg) return false;
        int wgid = (int)L; { const int q = nwg / NXCD, r = nwg % NXCD, xcd = wgid % NXCD, off = wgid / NXCD; wgid = (xcd < r ? xcd * (q + 1) : r * (q + 1) + (xcd - r) * q) + off; }
        const int nig = WGM * nN, gid = wgid / nig, fm = gid * WGM, gsz = (nM - fm) < WGM ? (nM - fm) : WGM;
        u.pm = fm + ((wgid % nig) % gsz); u.pn = (wgid % nig) / gsz; return true;
    }
    __device__ __forceinline__ void a_ready(const Unit&) const {}
    __device__ __forceinline__ void done(const Unit&) const {}
};

__device__ __forceinline__ unsigned cvt_pk_bf16(float lo, float hi) { unsigned r; asm volatile("v_cvt_pk_bf16_f32 %0, %1, %2" : "=v"(r) : "v"(lo), "v"(hi)); return r; }
template <class Epi, class Sched, bool ALIGN_EPI = false, bool SP2 = false>
__device__ __forceinline__ void gemm_phase(PG8_LAS unsigned char* lds, const Gemm g, const Sched& S, const Epi& E) {
    const int tid = threadIdx.x, wid = __builtin_amdgcn_readfirstlane(tid >> 6), lane = tid & 63, wr = wid >> 2, wc = wid & 3, fr = lane & 15, fq = lane >> 4;
    const int K = g.K, nt = K / BK;
    unsigned voffA[2], voffB[2];
#pragma unroll
    for (int i = 0; i < 2; ++i) { int R, C; stage_rc(tid * 16 + i * 8192, R, C); const int Rb = Epi::PERM ? ((R & ~31) + perm32(R & 31)) : R;
        voffA[i] = (unsigned)(R * K + C) * 2u; voffB[i] = (unsigned)(Rb * K + C) * 2u; }
    const size_t kstep = (size_t)(BK * 2);
    const size_t hstep = (size_t)HALF * K * 2;
    const size_t tstep = 2 * hstep;
    const unsigned ldsw = (unsigned)wid * 1024u;
    const int aoff = lds_byte(wr * 64 + fr, fq * 8), boff = lds_byte(wc * 32 + fr, fq * 8);
#define PG8_SA(b, h) (((b) * 2 + (h)) * HTB)
#define PG8_SB(b, h) ((4 + (b) * 2 + (h)) * HTB)
#define PG8_STAGE(bufoff, gbase, voff) do { _Pragma("unroll") for (int _i = 0; _i < 2; ++_i) \
        __builtin_amdgcn_global_load_lds((const unsigned*)((const char*)(gbase) + (voff)[_i]), (PG8_LAS unsigned*)(lds + (bufoff) + ldsw + _i * 8192), 16, 0, 0); } while (0)
#define PG8_LDA(dst, b, h) do { _Pragma("unroll") for (int m = 0; m < 4; ++m) _Pragma("unroll") for (int k = 0; k < 2; ++k) dst[m][k] = *(const PG8_LAS bf16x8*)(lds + PG8_SA(b, h) + aoff + m * 2048 + k * 1024); } while (0)
#define PG8_LDB(dst, b, h) do { _Pragma("unroll") for (int n = 0; n < 2; ++n) _Pragma("unroll") for (int k = 0; k < 2; ++k) dst[n][k] = *(const PG8_LAS bf16x8*)(lds + PG8_SB(b, h) + boff + n * 2048 + k * 1024); } while (0)
#define PG8_MMA(ai, bj, At, Bt) do { __builtin_amdgcn_s_setprio(1); _Pragma("unroll") for (int m = 0; m < 4; ++m) _Pragma("unroll") for (int n = 0; n < 2; ++n) _Pragma("unroll") for (int k = 0; k < 2; ++k) \
        acc[ai][bj][m][n] = __builtin_amdgcn_mfma_f32_16x16x32_bf16(Bt[n][k], At[m][k], acc[ai][bj][m][n], 0, 0, 0); __builtin_amdgcn_s_setprio(0); } while (0)
#define PG8_WAIT_V(n) asm volatile("s_waitcnt vmcnt(" #n ")" ::: "memory")
#define PG8_WAIT_L(n) asm volatile("s_waitcnt lgkmcnt(" #n ")" ::: "memory")
#define PG8_BAR __builtin_amdgcn_s_barrier()
#define PG8_SCHED __builtin_amdgcn_sched_barrier(0)
    Unit cur, nxt; int ui = 0;
    if (!S.next(0, cur)) return;
    f32x4 acc[2][2][4][2];
#pragma unroll
    for (int a = 0; a < 2; ++a)
#pragma unroll
        for (int b = 0; b < 2; ++b)
#pragma unroll
            for (int m = 0; m < 4; ++m)
#pragma unroll
                for (int n = 0; n < 2; ++n) acc[a][b][m][n] = (f32x4){0.f, 0.f, 0.f, 0.f};
    bf16x8 At[4][2], B0[2][2], B1[2][2];
    const char* cA = (const char*)g.A + (size_t)cur.pm * tstep; const char* cB = (const char*)g.Bt + (size_t)cur.pn * tstep;
    S.a_ready(cur);
    if constexpr (SP2) {
        PG8_STAGE(PG8_SB(0, 0), cB, voffB); PG8_STAGE(PG8_SB(0, 1), cB + hstep, voffB); PG8_STAGE(PG8_SA(0, 0), cA, voffA); PG8_STAGE(PG8_SA(0, 1), cA + hstep, voffA);
        if (wr == 1) PG8_BAR;
        PG8_WAIT_V(2); PG8_BAR;
        PG8_STAGE(PG8_SB(1, 0), cB + kstep, voffB); PG8_STAGE(PG8_SA(1, 0), cA + kstep, voffA); PG8_STAGE(PG8_SB(1, 1), cB + hstep + kstep, voffB);
        PG8_WAIT_V(6); PG8_BAR;
    } else {
        PG8_STAGE(PG8_SB(0, 0), cB, voffB); PG8_STAGE(PG8_SA(0, 0), cA, voffA); PG8_STAGE(PG8_SB(0, 1), cB + hstep, voffB); PG8_STAGE(PG8_SA(0, 1), cA + hstep, voffA);
        if (wr == 1) PG8_BAR;
        PG8_WAIT_V(4); PG8_BAR;
        PG8_STAGE(PG8_SB(1, 0), cB + kstep, voffB); PG8_STAGE(PG8_SA(1, 0), cA + kstep, voffA); PG8_STAGE(PG8_SB(1, 1), cB + hstep + kstep, voffB);
        PG8_WAIT_V(6); PG8_BAR;
    }
    for (;;) {
        const bool has_next = S.next(ui + 1, nxt);
        const char* nA = has_next ? (const char*)g.A + (size_t)nxt.pm * tstep : cA; const char* nB = has_next ? (const char*)g.Bt + (size_t)nxt.pn * tstep : cB;
        for (int t = 0; t < nt; t += 2) {
            const bool last = (t == nt - 2);
            const char* a1 = cA + (size_t)(t + 1) * kstep;
            const char* a2 = last ? nA : cA + (size_t)(t + 2) * kstep; const char* b2 = last ? nB : cB + (size_t)(t + 2) * kstep;
            const char* a3 = a2 + kstep; const char* b3 = b2 + kstep;
            if (last && has_next) S.a_ready(nxt);
            if constexpr (SP2) {
            PG8_LDB(B0, 0, 0); PG8_LDB(B1, 0, 1); PG8_SCHED; PG8_LDA(At, 0, 0); PG8_STAGE(PG8_SA(1, 1), a1 + hstep, voffA);
            PG8_WAIT_V(8); PG8_WAIT_L(0); PG8_BAR; PG8_MMA(0, 0, At, B0); PG8_MMA(0, 1, At, B1); PG8_BAR; PG8_SCHED;
            PG8_LDA(At, 0, 1); PG8_STAGE(PG8_SB(0, 0), b2, voffB); PG8_STAGE(PG8_SB(0, 1), b2 + hstep, voffB); PG8_STAGE(PG8_SA(0, 0), a2, voffA);
            PG8_WAIT_V(8); PG8_WAIT_L(0); PG8_BAR; PG8_MMA(1, 0, At, B0); PG8_MMA(1, 1, At, B1); PG8_BAR; PG8_SCHED;
            PG8_LDB(B0, 1, 0); PG8_LDB(B1, 1, 1); PG8_SCHED; PG8_LDA(At, 1, 0); PG8_STAGE(PG8_SA(0, 1), a2 + hstep, voffA);
            PG8_WAIT_V(8); PG8_WAIT_L(0); PG8_BAR; PG8_MMA(0, 0, At, B0); PG8_MMA(0, 1, At, B1); PG8_BAR; PG8_SCHED;
            PG8_LDA(At, 1, 1); PG8_STAGE(PG8_SB(1, 0), b3, voffB); PG8_STAGE(PG8_SB(1, 1), b3 + hstep, voffB); PG8_STAGE(PG8_SA(1, 0), a3, voffA);
            PG8_WAIT_V(8); PG8_WAIT_L(0); PG8_BAR; PG8_MMA(1, 0, At, B0); PG8_MMA(1, 1, At, B1); PG8_BAR; PG8_SCHED;
            } else {
            PG8_LDB(B0, 0, 0); PG8_SCHED; PG8_LDA(At, 0, 0); PG8_STAGE(PG8_SA(1, 1), a1 + hstep, voffA);
            PG8_WAIT_L(8); PG8_BAR; PG8_WAIT_L(0); PG8_MMA(0, 0, At, B0); PG8_BAR; PG8_SCHED;
            PG8_LDB(B1, 0, 1); PG8_STAGE(PG8_SB(0, 0), b2, voffB);
            PG8_BAR; PG8_WAIT_L(0); PG8_MMA(0, 1, At, B1); PG8_BAR;
            PG8_LDA(At, 0, 1); PG8_STAGE(PG8_SA(0, 0), a2, voffA);
            PG8_BAR; PG8_WAIT_L(0); PG8_MMA(1, 0, At, B0); PG8_BAR; PG8_SCHED;
            PG8_STAGE(PG8_SB(0, 1), b2 + hstep, voffB);
            PG8_WAIT_V(6); PG8_BAR; PG8_MMA(1, 1, At, B1); PG8_BAR;
            PG8_LDB(B0, 1, 0); PG8_SCHED; PG8_LDA(At, 1, 0); PG8_STAGE(PG8_SA(0, 1), a2 + hstep, voffA);
            PG8_WAIT_L(8); PG8_BAR; PG8_WAIT_L(0); PG8_MMA(0, 0, At, B0); PG8_BAR; PG8_SCHED;
            PG8_LDB(B1, 1, 1); PG8_STAGE(PG8_SB(1, 0), b3, voffB);
            PG8_BAR; PG8_WAIT_L(0); PG8_MMA(0, 1, At, B1); PG8_BAR;
            PG8_LDA(At, 1, 1); PG8_STAGE(PG8_SA(1, 0), a3, voffA);
            PG8_BAR; PG8_WAIT_L(0); PG8_MMA(1, 0, At, B0); PG8_BAR; PG8_SCHED;
            PG8_STAGE(PG8_SB(1, 1), b3 + hstep, voffB);
            PG8_WAIT_V(6); PG8_BAR; PG8_MMA(1, 1, At, B1); PG8_BAR;
            }
        }
        if constexpr (ALIGN_EPI) { if (wr == 0) PG8_BAR; }
        if constexpr (!Epi::AFTER_DRAIN) { E(acc, cur, wr, wc, fr, fq); S.done(cur); }
        if (!has_next) break;
#pragma unroll
        for (int a = 0; a < 2; ++a)
#pragma unroll
            for (int b = 0; b < 2; ++b)
#pragma unroll
                for (int m = 0; m < 4; ++m)
#pragma unroll
                    for (int n = 0; n < 2; ++n) acc[a][b][m][n] = (f32x4){0.f, 0.f, 0.f, 0.f};
        cur = nxt; cA = nA; cB = nB; ++ui;
        if constexpr (ALIGN_EPI) { if (wr == 1) PG8_BAR; }
    }
    PG8_WAIT_V(0);
    if constexpr (!ALIGN_EPI) { if (wr == 0) PG8_BAR; }
    PG8_BAR;
    if constexpr (Epi::AFTER_DRAIN) { E.fused(acc, cur, wr, wc, fr, fq, lds, wid, lane); S.done(cur); }
#undef PG8_SA
#undef PG8_SB
#undef PG8_STAGE
#undef PG8_LDA
#undef PG8_LDB
#undef PG8_MMA
#undef PG8_WAIT_V
#undef PG8_WAIT_L
#undef PG8_BAR
#undef PG8_SCHED
}
}
#ifndef PG8_SP2
#define PG8_SP2 true
#endif
#ifndef PG8_ALIGN
#define PG8_ALIGN true
#endif

constexpr int NB = 32, SEQ = 2048, DM = 1024, CTXL = 256;
constexpr int NLAT = NB * SEQ;
constexpr int NCTX = NB * CTXL;
constexpr int MTOT = NLAT + NCTX;
constexpr int NA = 4096, NBW = 2560;
constexpr float QSCALE = 0.125f * 1.4426950408889634f;
constexpr float LOG2E = 1.4426950408889634f;

#define LAS __attribute__((address_space(3)))
typedef unsigned short bf16;
typedef short bf16x8 __attribute__((ext_vector_type(8)));
typedef short s16x4 __attribute__((ext_vector_type(4)));
typedef float f32x4 __attribute__((ext_vector_type(4)));
typedef float f32x16 __attribute__((ext_vector_type(16)));
typedef unsigned u32x4 __attribute__((ext_vector_type(4)));
typedef unsigned u32x2 __attribute__((ext_vector_type(2)));
typedef float f32x2_t __attribute__((ext_vector_type(2)));
typedef __bf16 bf16x2_t __attribute__((ext_vector_type(2)));

constexpr size_t MiB = 1u << 20;
constexpr size_t WS_PAR = 0;
constexpr size_t WS_COS = 4096, WS_SIN = WS_COS + 2048 * 32 * 4;
constexpr size_t WS_MODX = 1 * MiB;
constexpr size_t WS_MODC = 2 * MiB;
constexpr size_t WS_WA = 4 * MiB;
constexpr size_t WS_WB = 12 * MiB;
constexpr size_t WS_WO = 18 * MiB;
constexpr size_t WS_CTX1 = 32 * MiB;
constexpr size_t WS_H = 64 * MiB;
constexpr size_t WS_AO = 208 * MiB;
constexpr size_t WS_QKV = 352 * MiB;
constexpr size_t WS_END = 928 * MiB;

constexpr int LDS_BYTES = 147456;
constexpr int NWAVES = 8;

__device__ __forceinline__ unsigned f2bf(float f) { unsigned u = __builtin_bit_cast(unsigned, f); return (u + 0x7fffu + ((u >> 16) & 1u)) >> 16; }
__device__ __forceinline__ unsigned pk2(float lo, float hi) { f32x2_t v = {lo, hi}; bf16x2_t b = __builtin_convertvector(v, bf16x2_t); return __builtin_bit_cast(unsigned, b); }
__device__ __forceinline__ float bf2f(unsigned short h) { return __builtin_bit_cast(float, (unsigned)h << 16); }
__device__ __forceinline__ float wave_sum(float v) {
#pragma unroll
    for (int o = 1; o < 64; o <<= 1) v += __shfl_xor(v, o);
    return v;
}
__device__ __forceinline__ float fast_exp2(float x) { return __builtin_amdgcn_exp2f(x); }
__device__ __forceinline__ float silu_f(float g) { return g * __builtin_amdgcn_rcpf(1.0f + fast_exp2(-g * LOG2E)); }

struct EpiIn {
    static constexpr bool PERM = true, AFTER_DRAIN = false;
    bf16* O; int ldc; int row_off, col_off; int rope_end, q_end, n_lat; const float* cosT; const float* sinT;
    __device__ __forceinline__ void operator()(const pg8::f32x4 (&acc)[2][2][4][2], const pg8::Unit& u, int wr, int wc, int fr, int fq) const {
        const int colt = col_off + u.pn * 256;
        const bool rope = colt < rope_end;
        const float sc = colt < q_end ? QSCALE : 1.0f;
        const int row0 = row_off + u.pm * 256 + wr * 64 + fr;
        const int col0 = colt + wc * 32 + 8 * fq;
        const bool lat = (row_off + u.pm * 256) < n_lat;
        const float sgn = fq < 2 ? -1.0f : 1.0f;
        const int tabc = (wc & 1) * 16 + 8 * (fq & 1);
#pragma unroll
        for (int ai = 0; ai < 2; ++ai)
#pragma unroll
            for (int m = 0; m < 4; ++m) {
                const int row = row0 + ai * 128 + m * 16;
                bf16* rowp = O + (size_t)row * ldc + col0;
                f32x4 c0 = {1.f, 1.f, 1.f, 1.f}, c1 = c0, s0 = {0.f, 0.f, 0.f, 0.f}, s1 = s0;
                const bool dorope = rope && lat;
                if (dorope) {
                    const int t = row & (SEQ - 1);
                    c0 = *(const f32x4*)(cosT + t * 32 + tabc); c1 = *(const f32x4*)(cosT + t * 32 + tabc + 4);
                    s0 = *(const f32x4*)(sinT + t * 32 + tabc) * sgn; s1 = *(const f32x4*)(sinT + t * 32 + tabc + 4) * sgn;
                }
#pragma unroll
                for (int bj = 0; bj < 2; ++bj) {
                    f32x4 v0 = acc[ai][bj][m][0], v1 = acc[ai][bj][m][1];
                    if (dorope) {
                        f32x4 p0, p1;
#pragma unroll
                        for (int e = 0; e < 4; ++e) { p0[e] = __shfl_xor(v0[e], 32); p1[e] = __shfl_xor(v1[e], 32); }
                        v0 = v0 * c0 + p0 * s0; v1 = v1 * c1 + p1 * s1;
                    }
                    v0 = v0 * sc; v1 = v1 * sc;
                    u32x4 w; w.x = pk2(v0[0], v0[1]); w.y = pk2(v0[2], v0[3]); w.z = pk2(v1[0], v1[1]); w.w = pk2(v1[2], v1[3]);
                    *(u32x4*)(rowp + bj * 128) = w;
                }
            }
    }
};
struct EpiOut {
    static constexpr bool PERM = false, AFTER_DRAIN = false;
    const float* base_lat; const float* base_ctx; float* out_lat; float* out_ctx; const float* gate_lat; const float* gate_ctx; int n_lat;
    __device__ __forceinline__ void operator()(const pg8::f32x4 (&acc)[2][2][4][2], const pg8::Unit& u, int wr, int wc, int fr, int fq) const {
        const int rowt = u.pm * 256;
        const bool lat = rowt < n_lat;
        const float* g = lat ? gate_lat + (size_t)(rowt >> 11) * 3072 : gate_ctx;
        const float* bs = lat ? base_lat + (size_t)rowt * DM : base_ctx + (size_t)(rowt - n_lat) * DM;
        float* op = lat ? out_lat + (size_t)rowt * DM : out_ctx + (size_t)(rowt - n_lat) * DM;
        const int col0 = u.pn * 256 + wc * 32 + 4 * fq;
        f32x4 gv[2][2];
#pragma unroll
        for (int bj = 0; bj < 2; ++bj)
#pragma unroll
            for (int n = 0; n < 2; ++n) gv[bj][n] = *(const f32x4*)(g + col0 + bj * 128 + n * 16);
#pragma unroll
        for (int ai = 0; ai < 2; ++ai)
#pragma unroll
            for (int m = 0; m < 4; ++m) {
                const size_t off = (size_t)(wr * 64 + fr + ai * 128 + m * 16) * DM + col0;
#pragma unroll
                for (int bj = 0; bj < 2; ++bj)
#pragma unroll
                    for (int n = 0; n < 2; ++n) {
                        const f32x4 b4 = *(const f32x4*)(bs + off + bj * 128 + n * 16);
                        *(f32x4*)(op + off + bj * 128 + n * 16) = b4 + gv[bj][n] * acc[ai][bj][m][n];
                    }
            }
    }
};

__device__ __forceinline__ unsigned off_b(unsigned row, unsigned ch) { return 256u * row + 16u * (ch ^ (((row & 3u) << 2) | ((row >> 2) & 3u))); }
__device__ __forceinline__ int crow(int r, int hi) { return (r & 3) + 8 * (r >> 2) + 4 * hi; }
__device__ __forceinline__ s16x4 tr_read(const LAS unsigned char* p) { return __builtin_bit_cast(s16x4, __builtin_amdgcn_ds_read_tr16_b64_v4i16((LAS s16x4*)p)); }

__device__ __forceinline__ void qk_tile(f32x16& s0, f32x16& s1, const LAS unsigned char* img, const unsigned (&koff)[4], const bf16x8 (&qf)[4]) {
    s0 = f32x16{}; s1 = f32x16{};
#pragma unroll
    for (int d0 = 0; d0 < 4; ++d0) {
        const bf16x8 a0 = *(const LAS bf16x8*)(img + koff[d0]);
        const bf16x8 a1 = *(const LAS bf16x8*)(img + koff[d0] + 8192);
        s0 = __builtin_amdgcn_mfma_f32_32x32x16_bf16(a0, qf[d0], s0, 0, 0, 0);
        s1 = __builtin_amdgcn_mfma_f32_32x32x16_bf16(a1, qf[d0], s1, 0, 0, 0);
    }
}
__device__ __forceinline__ float softmax_tile(f32x16& s0, f32x16& s1, float& m, float& l, bf16x8 (&pw)[4]) {
    float tmax = fmaxf(s0[0], s1[0]);
#pragma unroll
    for (int r = 1; r < 16; ++r) tmax = fmaxf(tmax, fmaxf(s0[r], s1[r]));
    tmax = fmaxf(tmax, __shfl_xor(tmax, 32));
    const float mnew = fmaxf(m, tmax);
    const float alpha = fast_exp2(m - mnew);
    m = mnew;
    float ps = 0.f;
#pragma unroll
    for (int r = 0; r < 16; ++r) { s0[r] = fast_exp2(s0[r] - mnew); s1[r] = fast_exp2(s1[r] - mnew); ps += s0[r] + s1[r]; }
    l = l * alpha + ps;
#pragma unroll
    for (int c = 0; c < 4; ++c) {
        u32x4 w;
        if (c < 2) { const int b = 8 * (c & 1); w.x = pk2(s0[b], s0[b + 1]); w.y = pk2(s0[b + 2], s0[b + 3]); w.z = pk2(s0[b + 4], s0[b + 5]); w.w = pk2(s0[b + 6], s0[b + 7]); }
        else       { const int b = 8 * (c & 1); w.x = pk2(s1[b], s1[b + 1]); w.y = pk2(s1[b + 2], s1[b + 3]); w.z = pk2(s1[b + 4], s1[b + 5]); w.w = pk2(s1[b + 6], s1[b + 7]); }
        pw[c] = __builtin_bit_cast(bf16x8, w);
    }
    return alpha;
}
template <int NDB>
__device__ __forceinline__ void pv_tile(f32x16 (&o)[NDB], const LAS unsigned char* vimg, const unsigned (&vb)[2][NDB], const bf16x8 (&pw)[4]) {
#pragma unroll
    for (int db = 0; db < NDB; ++db)
#pragma unroll
        for (int c = 0; c < 4; ++c) {
            const s16x4 lo = tr_read(vimg + vb[0][db] + 4096 * c);
            const s16x4 hi = tr_read(vimg + vb[1][db] + 4096 * c);
            const bf16x8 a = (bf16x8){lo[0], lo[1], lo[2], lo[3], hi[0], hi[1], hi[2], hi[3]};
            o[db] = __builtin_amdgcn_mfma_f32_32x32x16_bf16(a, pw[c], o[db], 0, 0, 0);
        }
}
template <int NDB>
__device__ __forceinline__ void make_vb(unsigned (&vb)[2][NDB], int lane, int chbase) {
    const unsigned hi = lane >> 5, blk = (lane >> 4) & 1, q4 = (lane & 15) >> 2, p = lane & 3;
#pragma unroll
    for (int t = 0; t < 2; ++t)
#pragma unroll
        for (int db = 0; db < NDB; ++db)
            vb[t][db] = off_b(8 * t + 4 * hi + q4, chbase + 4 * db + 2 * blk + (p >> 1)) + 8 * (p & 1);
}

__device__ __forceinline__ void diff_attn_unit(LAS unsigned char* lds, const bf16* __restrict__ QKV, bf16* __restrict__ AO, int rowq0, int ctx_row0, int lat_row0, int T, int h,
                                               float lam, const float* __restrict__ subln_g) {
    const int tid = threadIdx.x, lane = tid & 63, wid = __builtin_amdgcn_readfirstlane(tid >> 6), r32 = lane & 31, hi = lane >> 5;
    const int map = wid >> 2, qg = wid & 3;
    const int qrow = rowq0 + qg * 32 + r32;
    bf16x8 qf[4];
    {
        const bf16* qp = QKV + (size_t)qrow * NA + h * 128 + map * 64 + hi * 8;
#pragma unroll
        for (int d0 = 0; d0 < 4; ++d0) qf[d0] = *(const bf16x8*)(qp + d0 * 16);
    }
    unsigned koff[4];
    {
        const unsigned kx = ((r32 & 3) << 2) | ((r32 >> 2) & 3);
#pragma unroll
        for (int d0 = 0; d0 < 4; ++d0) koff[d0] = 256u * r32 + 16u * ((unsigned)(8 * map + 2 * d0 + hi) ^ kx);
    }
    unsigned vb[2][4]; make_vb<4>(vb, lane, 0);
    const int srow = tid >> 4, sch = tid & 15;
    const unsigned sdst0 = off_b(srow, sch), sdst1 = off_b(srow + 32, sch);
    const bf16* kcol = QKV + 1024 + h * 128 + sch * 8;
    const bf16* vcol = QKV + 2048 + h * 128 + sch * 8;
    u32x4 kr0, kr1, vr0, vr1;
#define DA_LOAD(t) do { const size_t kr_ = (size_t)(((t) < 4 ? ctx_row0 + (t) * 64 : lat_row0 + ((t) - 4) * 64) + srow) * NA; \
        kr0 = *(const u32x4*)(kcol + kr_); kr1 = *(const u32x4*)(kcol + kr_ + (size_t)32 * NA); vr0 = *(const u32x4*)(vcol + kr_); vr1 = *(const u32x4*)(vcol + kr_ + (size_t)32 * NA); } while (0)
#define DA_STORE(st) do { LAS unsigned char* b_ = lds + (st) * 32768; *(LAS u32x4*)(b_ + sdst0) = kr0; *(LAS u32x4*)(b_ + sdst1) = kr1; \
        *(LAS u32x4*)(b_ + 16384 + sdst0) = vr0; *(LAS u32x4*)(b_ + 16384 + sdst1) = vr1; } while (0)
    f32x16 o[4]; o[0] = f32x16{}; o[1] = f32x16{}; o[2] = f32x16{}; o[3] = f32x16{};
    float m = -1e30f, l = 0.f;
    DA_LOAD(0); DA_STORE(0); __syncthreads();
    for (int t = 0; t < T; ++t) {
        const bool more = t + 1 < T;
        if (more) DA_LOAD(t + 1);
        const LAS unsigned char* img = lds + (t & 1) * 32768;
        f32x16 s0, s1; bf16x8 pw[4];
        qk_tile(s0, s1, img, koff, qf);
        const float alpha = softmax_tile(s0, s1, m, l, pw);
        if (__any(alpha != 1.0f)) {
#pragma unroll
            for (int db = 0; db < 4; ++db) o[db] = o[db] * alpha;
        }
        pv_tile<4>(o, img + 16384, vb, pw);
        if (more) DA_STORE((t + 1) & 1);
        __syncthreads();
    }
#undef DA_LOAD
#undef DA_STORE
    l += __shfl_xor(l, 32);
    LAS float* X = (LAS float*)(lds + qg * 17408);
    if (map == 1) {
        const float inv = lam / l;
#pragma unroll
        for (int db = 0; db < 4; ++db)
#pragma unroll
            for (int r = 0; r < 16; ++r) X[(db * 16 + r) * 64 + lane] = o[db][r] * inv;
    }
    __syncthreads();
    if (map == 0) {
        const float inv = 1.0f / l;
        float ss = 0.f;
#pragma unroll
        for (int db = 0; db < 4; ++db)
#pragma unroll
            for (int r = 0; r < 16; ++r) { const float v = o[db][r] * inv - X[(db * 16 + r) * 64 + lane]; o[db][r] = v; ss += v * v; }
        ss += __shfl_xor(ss, 32);
        const float rstd = __builtin_amdgcn_rsqf(ss * (1.0f / 128.0f) + 1e-5f) * 0.8f;
        asm volatile("s_waitcnt lgkmcnt(0)" ::: "memory");
#pragma unroll
        for (int db = 0; db < 4; ++db)
#pragma unroll
            for (int k = 0; k < 4; ++k) {
                f32x4 y; y[0] = o[db][4 * k] * rstd; y[1] = o[db][4 * k + 1] * rstd; y[2] = o[db][4 * k + 2] * rstd; y[3] = o[db][4 * k + 3] * rstd;
                *(LAS f32x4*)(X + r32 * 132 + 32 * db + 8 * k + 4 * hi) = y;
            }
        asm volatile("s_waitcnt lgkmcnt(0)" ::: "memory");
        const int dc = 8 * (lane & 15);
        const f32x4 sg0 = *(const f32x4*)(subln_g + dc), sg1 = *(const f32x4*)(subln_g + dc + 4);
        const int rbase = rowq0 + qg * 32;
#pragma unroll 2
        for (int i = 0; i < 8; ++i) {
            const int rr = 4 * i + (lane >> 4);
            const f32x4 y0 = *(const LAS f32x4*)(X + rr * 132 + dc), y1 = *(const LAS f32x4*)(X + rr * 132 + dc + 4);
            const u32x4 g4 = *(const u32x4*)(QKV + (size_t)(rbase + rr) * NA + 3072 + h * 128 + dc);
            float gf[8];
            gf[0] = __builtin_bit_cast(float, g4.x << 16); gf[1] = __builtin_bit_cast(float, g4.x & 0xffff0000u);
            gf[2] = __builtin_bit_cast(float, g4.y << 16); gf[3] = __builtin_bit_cast(float, g4.y & 0xffff0000u);
            gf[4] = __builtin_bit_cast(float, g4.z << 16); gf[5] = __builtin_bit_cast(float, g4.z & 0xffff0000u);
            gf[6] = __builtin_bit_cast(float, g4.w << 16); gf[7] = __builtin_bit_cast(float, g4.w & 0xffff0000u);
            u32x4 w;
            w.x = pk2(y0[0] * sg0[0] * silu_f(gf[0]), y0[1] * sg0[1] * silu_f(gf[1]));
            w.y = pk2(y0[2] * sg0[2] * silu_f(gf[2]), y0[3] * sg0[3] * silu_f(gf[3]));
            w.z = pk2(y1[0] * sg1[0] * silu_f(gf[4]), y1[1] * sg1[1] * silu_f(gf[5]));
            w.w = pk2(y1[2] * sg1[2] * silu_f(gf[6]), y1[3] * sg1[3] * silu_f(gf[7]));
            *(u32x4*)(AO + (size_t)(rbase + rr) * DM + h * 128 + dc) = w;
        }
    }
    __syncthreads();
}

__device__ __forceinline__ void win_attn_unit(LAS unsigned char* lds, const bf16* __restrict__ QKV, bf16* __restrict__ AO, int b, int kvh, int qb, const float* __restrict__ sink) {
    const int tid = threadIdx.x, lane = tid & 63, wid = __builtin_amdgcn_readfirstlane(tid >> 6), r32 = lane & 31, hi = lane >> 5;
    const int g = wid & 3, rg = wid >> 2, head = kvh * 4 + g;
    const int qpos = qb * 64 + rg * 32 + r32;
    const int qrow = b * SEQ + qpos;
    bf16x8 qf[4];
    {
        const bf16* qp = QKV + (size_t)qrow * NBW + head * 64 + hi * 8;
#pragma unroll
        for (int d0 = 0; d0 < 4; ++d0) qf[d0] = *(const bf16x8*)(qp + d0 * 16);
    }
    unsigned koff[4];
    {
        const unsigned kx = ((r32 & 3) << 2) | ((r32 >> 2) & 3);
#pragma unroll
        for (int d0 = 0; d0 < 4; ++d0) koff[d0] = 256u * r32 + 16u * ((unsigned)(2 * d0 + hi) ^ kx);
    }
    unsigned vb[2][2]; make_vb<2>(vb, lane, 8);
    const int srow = tid >> 4, sch = tid & 15;
    const unsigned sdst0 = off_b(srow, sch), sdst1 = off_b(srow + 32, sch);
    const bf16* scol = QKV + (sch < 8 ? 1024 + kvh * 64 + sch * 8 : 1280 + kvh * 64 + (sch - 8) * 8);
    const int kt_lo = qb - 2 < 0 ? 0 : qb - 2, kt_hi = qb + 2 > 31 ? 31 : qb + 2;
    const int T = 4 + (kt_hi - kt_lo + 1);
    const int ctx_row0 = NLAT + b * CTXL, lat_row0 = b * SEQ;
    u32x4 r0, r1;
#define WA_LOAD(t) do { const size_t kr_ = (size_t)(((t) < 4 ? ctx_row0 + (t) * 64 : lat_row0 + (kt_lo + (t) - 4) * 64) + srow) * NBW; \
        r0 = *(const u32x4*)(scol + kr_); r1 = *(const u32x4*)(scol + kr_ + (size_t)32 * NBW); } while (0)
#define WA_STORE(st) do { LAS unsigned char* b_ = lds + (st) * 16384; *(LAS u32x4*)(b_ + sdst0) = r0; *(LAS u32x4*)(b_ + sdst1) = r1; } while (0)
    f32x16 o[2]; o[0] = f32x16{}; o[1] = f32x16{};
    float m = -1e30f, l = 0.f;
    WA_LOAD(0); WA_STORE(0); __syncthreads();
    for (int t = 0; t < T; ++t) {
        const bool more = t + 1 < T;
        if (more) WA_LOAD(t + 1);
        const LAS unsigned char* img = lds + (t & 1) * 16384;
        f32x16 s0, s1; bf16x8 pw[4];
        qk_tile(s0, s1, img, koff, qf);
        if (t >= 4) {
            const int kt = kt_lo + t - 4;
            if (kt == qb - 2 || kt == qb + 2) {
                const int kbase = kt * 64 - qpos;
#pragma unroll
                for (int r = 0; r < 16; ++r) {
                    const int d0_ = kbase + crow(r, hi), d1_ = d0_ + 32;
                    if (d0_ > 128 || d0_ < -128) s0[r] = -1e30f;
                    if (d1_ > 128 || d1_ < -128) s1[r] = -1e30f;
                }
            }
        }
        const float alpha = softmax_tile(s0, s1, m, l, pw);
        if (__any(alpha != 1.0f)) { o[0] = o[0] * alpha; o[1] = o[1] * alpha; }
        pv_tile<2>(o, img, vb, pw);
        if (more) WA_STORE((t + 1) & 1);
        __syncthreads();
    }
#undef WA_LOAD
#undef WA_STORE
    l += __shfl_xor(l, 32);
    l += fast_exp2(sink[head] * LOG2E - m);
    const float inv = 1.0f / l;
    const bf16* gp = QKV + (size_t)qrow * NBW + 1536 + head * 64 + 4 * hi;
    bf16* op = AO + (size_t)qrow * DM + head * 64 + 4 * hi;
#pragma unroll
    for (int db = 0; db < 2; ++db)
#pragma unroll
        for (int k = 0; k < 4; ++k) {
            const int d = 32 * db + 8 * k;
            const u32x2 g2 = *(const u32x2*)(gp + d);
            const float g0 = __builtin_bit_cast(float, g2.x << 16), g1 = __builtin_bit_cast(float, g2.x & 0xffff0000u);
            const float g2f = __builtin_bit_cast(float, g2.y << 16), g3 = __builtin_bit_cast(float, g2.y & 0xffff0000u);
            const float y0 = o[db][4 * k + 0] * inv * silu_f(g0), y1 = o[db][4 * k + 1] * inv * silu_f(g1);
            const float y2 = o[db][4 * k + 2] * inv * silu_f(g2f), y3 = o[db][4 * k + 3] * inv * silu_f(g3);
            u32x2 w; w.x = pk2(y0, y1); w.y = pk2(y2, y3);
            *(u32x2*)(op + d) = w;
        }
}

__device__ __forceinline__ void transpose_item(const float* __restrict__ W, int K, int N, bf16* __restrict__ WT, LAS float* scr, int item, int lane) {
    const int nblk = N / 32, kb = item / nblk, nb = item % nblk, k0 = 64 * kb, n0 = 32 * nb;
#pragma unroll 8
    for (int i = 0; i < 32; ++i) { const int kk = 2 * i + (lane >> 5); scr[kk * 33 + (lane & 31)] = W[(size_t)(k0 + kk) * N + n0 + (lane & 31)]; }
    asm volatile("s_waitcnt lgkmcnt(0)" ::: "memory");
    const int c = lane & 7;
#pragma unroll
    for (int j = 0; j < 4; ++j) { const int n = (lane >> 3) + 8 * j; const LAS float* s = scr + (8 * c) * 33 + n;
        u32x4 o; o.x = pk2(s[0 * 33], s[1 * 33]); o.y = pk2(s[2 * 33], s[3 * 33]); o.z = pk2(s[4 * 33], s[5 * 33]); o.w = pk2(s[6 * 33], s[7 * 33]);
        *(u32x4*)(WT + (size_t)(n0 + n) * K + k0 + 8 * c) = o; }
    asm volatile("s_waitcnt lgkmcnt(0)" ::: "memory");
}
__device__ __forceinline__ void norm_mod_pass(const float* __restrict__ xlat, const float* __restrict__ xctx, const float* __restrict__ g, const float* __restrict__ modx,
                                              const float* __restrict__ modc, bf16* __restrict__ H, int gw, int ngw, int lane) {
    for (int mrow = gw; mrow < MTOT; mrow += ngw) {
        const bool lat = mrow < NLAT;
        const float* src = lat ? xlat + (size_t)mrow * DM : xctx + (size_t)(mrow - NLAT) * DM;
        const float* mod = lat ? modx + (size_t)(mrow >> 11) * 3072 : modc;
        f32x4 v[4]; float ss = 0.f;
#pragma unroll
        for (int j = 0; j < 4; ++j) { v[j] = *(const f32x4*)(src + 4 * (lane + 64 * j)); ss += (v[j][0] * v[j][0] + v[j][1] * v[j][1]) + (v[j][2] * v[j][2] + v[j][3] * v[j][3]); }
        const float rstd = 1.0f / sqrtf(wave_sum(ss) * (1.0f / DM) + 1e-6f);
#pragma unroll
        for (int j = 0; j < 4; ++j) {
            const int col = 4 * (lane + 64 * j);
            const f32x4 gg = *(const f32x4*)(g + col), sh = *(const f32x4*)(mod + col), sc = *(const f32x4*)(mod + 1024 + col);
            const f32x4 hh = v[j] * rstd * gg * (sc + 1.0f) + sh;
            u32x2 w; w.x = pk2(hh[0], hh[1]); w.y = pk2(hh[2], hh[3]);
            *(u32x2*)(H + (size_t)mrow * DM + col) = w;
        }
    }
}
__device__ __forceinline__ void final_norm_pass(float* __restrict__ xo, const float* __restrict__ g, int gw, int ngw, int lane) {
    for (int mrow = gw; mrow < NLAT; mrow += ngw) {
        float* src = xo + (size_t)mrow * DM;
        f32x4 v[4]; float ss = 0.f;
#pragma unroll
        for (int j = 0; j < 4; ++j) { v[j] = *(const f32x4*)(src + 4 * (lane + 64 * j)); ss += (v[j][0] * v[j][0] + v[j][1] * v[j][1]) + (v[j][2] * v[j][2] + v[j][3] * v[j][3]); }
        const float rstd = 1.0f / sqrtf(wave_sum(ss) * (1.0f / DM) + 1e-6f);
#pragma unroll
        for (int j = 0; j < 4; ++j) { const int col = 4 * (lane + 64 * j); const f32x4 gg = *(const f32x4*)(g + col); *(f32x4*)(src + col) = v[j] * rstd * gg; }
    }
}

struct Args {
    const float *x, *c, *ctx, *c_ctx, *w_mod, *b_mod, *norm_g, *w_o, *a_w_in, *lq1, *lk1, *lq2, *lk2, *subln_g, *b_w_in, *b_sink, *final_g;
    float* out; unsigned char* ws; int ph_lo, ph_hi;
};

__global__ void __launch_bounds__(NWAVES * 64, 2) fwd_kernel(Args a) {
    extern __shared__ __attribute__((aligned(16))) unsigned char lds_raw[];
    LAS unsigned char* lds = (LAS unsigned char*)lds_raw;
    cg::grid_group grid = cg::this_grid();
    const int tid = threadIdx.x, lane = tid & 63, wave = __builtin_amdgcn_readfirstlane(tid >> 6);
    const int G = gridDim.x, bx = blockIdx.x;
    const int vcu = (G % 8 == 0) ? (bx % 8) * (G / 8) + bx / 8 : bx;
    const int gw = vcu * NWAVES + wave, ngw = G * NWAVES;
    unsigned char* ws = a.ws;
    float* par = (float*)(ws + WS_PAR);
    float* cosT = (float*)(ws + WS_COS); float* sinT = (float*)(ws + WS_SIN);
    float* modx = (float*)(ws + WS_MODX); float* modc = (float*)(ws + WS_MODC);
    bf16* WA = (bf16*)(ws + WS_WA); bf16* WB = (bf16*)(ws + WS_WB); bf16* WO = (bf16*)(ws + WS_WO);
    float* CTX1 = (float*)(ws + WS_CTX1);
    bf16* H = (bf16*)(ws + WS_H); bf16* AO = (bf16*)(ws + WS_AO); bf16* QKV = (bf16*)(ws + WS_QKV);
    const int lo = a.ph_lo, hi_ph = a.ph_hi;
#ifndef PHMASK
#define PHMASK 0x3ff
#endif
#define IN(k) (((PHMASK >> (k)) & 1) && lo <= (k) && (k) < hi_ph)
#define SEAM(k) do { if (IN(k) && IN((k) + 1)) grid.sync(); } while (0)

    if (IN(0)) {
        if (bx < 96) {
            LAS float* S = (LAS float*)lds;
            for (int idx = tid; idx < 33 * 1024; idx += NWAVES * 64) { const float v = idx < 32 * 1024 ? a.c[idx] : a.c_ctx[idx - 32 * 1024]; S[idx] = silu_f(v); }
            __syncthreads();
            const int li = bx / 48, n0 = (bx % 48) * 64;
            float acc[33];
#pragma unroll
            for (int r = 0; r < 33; ++r) acc[r] = 0.f;
            const float* w = a.w_mod + (size_t)li * 1024 * 3072 + n0 + lane;
            for (int kk = 0; kk < 128; kk += 4) {
                const int k = wave * 128 + kk;
                const float w0 = w[(size_t)k * 3072], w1 = w[(size_t)(k + 1) * 3072], w2 = w[(size_t)(k + 2) * 3072], w3 = w[(size_t)(k + 3) * 3072];
#pragma unroll
                for (int r = 0; r < 33; ++r) { const f32x4 s = *(const LAS f32x4*)(S + r * 1024 + k); acc[r] += (s[0] * w0 + s[1] * w1) + (s[2] * w2 + s[3] * w3); }
            }
            __syncthreads();
            LAS float* red = (LAS float*)lds;
#pragma unroll
            for (int r = 0; r < 33; ++r) red[(wave * 33 + r) * 64 + lane] = acc[r];
            __syncthreads();
            for (int idx = tid; idx < 33 * 64; idx += NWAVES * 64) {
                const int r = idx >> 6, l = idx & 63; float s = 0.f;
#pragma unroll
                for (int w8 = 0; w8 < 8; ++w8) s += red[(w8 * 33 + r) * 64 + l];
                s += a.b_mod[li * 3072 + n0 + l];
                if (r < 32) modx[(size_t)(li * 32 + r) * 3072 + n0 + l] = s; else modc[li * 3072 + n0 + l] = s;
            }
            __syncthreads();
        }
        {
            LAS float* scr = (LAS float*)(lds + wave * 16384);
            constexpr int I_A = 16 * (NA / 32), I_B = 16 * (NBW / 32), I_O = 16 * (DM / 32);
            constexpr int NITEMS = I_A + I_B + 2 * I_O;
            for (int it = gw; it < NITEMS; it += ngw) {
                int r = it;
                if (r < I_A) { transpose_item(a.a_w_in, DM, NA, WA, scr, r, lane); continue; } r -= I_A;
                if (r < I_B) { transpose_item(a.b_w_in, DM, NBW, WB, scr, r, lane); continue; } r -= I_B;
                if (r < I_O) { transpose_item(a.w_o, DM, DM, WO, scr, r, lane); continue; } r -= I_O;
                transpose_item(a.w_o + (size_t)DM * DM, DM, DM, WO + (size_t)DM * DM, scr, r, lane);
            }
        }
        for (int idx = gw * 64 + lane; idx < 2048 * 32; idx += ngw * 64) {
            const int t = idx >> 5, j = idx & 31, i = j & 15;
            const float pos = (float)(j < 16 ? (t >> 6) : (t & 63));
            const float invf = exp2f(-(float)i * (13.287712379549449f / 16.0f));
            const float ang = pos * invf;
            cosT[idx] = __cosf(ang); sinT[idx] = __sinf(ang);
        }
        if (bx == G - 1 && wave == 0) {
            const float p1 = wave_sum(a.lq1[lane] * a.lk1[lane]), p2 = wave_sum(a.lq2[lane] * a.lk2[lane]);
            if (lane == 0) par[0] = expf(p1) - expf(p2) + 0.2f;
        }
    }
    SEAM(0);
    if (IN(1)) norm_mod_pass(a.x, a.ctx, a.norm_g, modx, modc, H, gw, ngw, lane);
    SEAM(1);
    if (IN(2)) {
        pg8::Gemm g{H, WA, MTOT, NA, DM}; pg8::StaticOrder S; S.init(MTOT, NA, G, bx);
        EpiIn E{QKV, NA, 0, 0, 2048, 1024, NLAT, cosT, sinT};
        pg8::gemm_phase<EpiIn, pg8::StaticOrder, PG8_ALIGN, PG8_SP2>(lds, g, S, E);
    }
    SEAM(2);
    if (IN(3)) {
        const float lam = par[0];
        for (int L = vcu; L < 4096; L += G) {
            const int i = L >> 8, v = L & 255, xq = v >> 5, j = v & 31;
            const int pair = 32 * xq + 2 * i + (j >> 4), qb = j & 15, b = pair >> 3, h = pair & 7;
            diff_attn_unit(lds, QKV, AO, b * SEQ + qb * 128, NLAT + b * CTXL, b * SEQ, 36, h, lam, a.subln_g);
        }
        for (int L = vcu; L < 512; L += G) {
            const int pair = L >> 1, qb = L & 1, b = pair >> 3, h = pair & 7;
            diff_attn_unit(lds, QKV, AO, NLAT + b * CTXL + qb * 128, NLAT + b * CTXL, 0, 4, h, lam, a.subln_g);
        }
    }
    SEAM(3);
    if (IN(4)) {
        pg8::Gemm g{AO, WO, MTOT, DM, DM}; pg8::StaticOrder S; S.init(MTOT, DM, G, bx);
        EpiOut E{a.x, a.ctx, a.out, CTX1, modx + 2048, modc + 2048, NLAT};
        pg8::gemm_phase<EpiOut, pg8::StaticOrder, PG8_ALIGN, PG8_SP2>(lds, g, S, E);
    }
    SEAM(4);
    if (IN(5)) norm_mod_pass(a.out, CTX1, a.norm_g + DM, modx + 32 * 3072, modc + 3072, H, gw, ngw, lane);
    SEAM(5);
    if (IN(6)) {
        {
            pg8::Gemm g{H, WB, NLAT, NBW, DM}; pg8::StaticOrder S; S.init(NLAT, NBW, G, bx);
            EpiIn E{QKV, NBW, 0, 0, 1280, 1024, NLAT, cosT, sinT};
            pg8::gemm_phase<EpiIn, pg8::StaticOrder, PG8_ALIGN, PG8_SP2>(lds, g, S, E);
        }
        {
            pg8::Gemm g{H + (size_t)NLAT * DM, WB + (size_t)1024 * DM, NCTX, 512, DM}; pg8::StaticOrder S; S.init(NCTX, 512, G, bx);
            EpiIn E{QKV, NBW, NLAT, 1024, 1280, 1024, NLAT, cosT, sinT};
            pg8::gemm_phase<EpiIn, pg8::StaticOrder, PG8_ALIGN, PG8_SP2>(lds, g, S, E);
        }
    }
    SEAM(6);
    if (IN(7)) {
        for (int L = vcu; L < 4096; L += G) {
            const int i = L >> 8, v = L & 255, pair = v >> 1, qb = (v & 1) * 16 + i, b = pair >> 2, kvh = pair & 3;
            win_attn_unit(lds, QKV, AO, b, kvh, qb, a.b_sink);
        }
    }
    SEAM(7);
    if (IN(8)) {
        pg8::Gemm g{AO, WO + (size_t)DM * DM, NLAT, DM, DM}; pg8::StaticOrder S; S.init(NLAT, DM, G, bx);
        EpiOut E{a.out, a.out, a.out, a.out, modx + 32 * 3072 + 2048, modc + 3072 + 2048, NLAT};
        pg8::gemm_phase<EpiOut, pg8::StaticOrder, PG8_ALIGN, PG8_SP2>(lds, g, S, E);
    }
    SEAM(8);
    if (IN(9)) final_norm_pass(a.out, a.final_g, gw, ngw, lane);
#undef IN
#undef SEAM
}

#ifndef MK_PER_PHASE
#define MK_PER_PHASE 0
#endif
extern "C" void kernel_launch(void* const* d_in, const int* in_sizes, int n_in, void* d_out, int out_size, void* d_ws, size_t ws_size, hipStream_t stream) {
    static int grid = 0;
    if (grid == 0) {
        if (n_in != 17 || in_sizes[0] != NLAT * DM || out_size != NLAT * DM || ws_size < WS_END) {
            fprintf(stderr, "kernel_launch: unexpected shapes: n_in %d in0 %d out %d ws %zu\n", n_in, n_in > 0 ? in_sizes[0] : -1, out_size, ws_size); grid = -1; return; }
        int dev = 0, cus = 0, per_cu = 0;
        hipGetDevice(&dev);
        hipDeviceGetAttribute(&cus, hipDeviceAttributeMultiprocessorCount, dev);
        if (hipFuncSetAttribute((const void*)fwd_kernel, hipFuncAttributeMaxDynamicSharedMemorySize, LDS_BYTES) != hipSuccess) { fprintf(stderr, "kernel_launch: hipFuncSetAttribute failed\n"); grid = -1; return; }
        if (hipOccupancyMaxActiveBlocksPerMultiprocessor(&per_cu, (const void*)fwd_kernel, NWAVES * 64, LDS_BYTES) != hipSuccess || per_cu < 1) { fprintf(stderr, "kernel_launch: occupancy query says %d blocks per CU\n", per_cu); per_cu = 1; }
        (void)hipGetLastError();
        grid = cus * (per_cu > 1 ? 1 : per_cu);
    }
    if (grid < 0) return;
    Args a{};
    const float** f = (const float**)&a;
    for (int i = 0; i < 17; ++i) f[i] = (const float*)d_in[i];
    a.out = (float*)d_out; a.ws = (unsigned char*)d_ws;
#if MK_PER_PHASE
    for (int p = 0; p < 10; ++p) { a.ph_lo = p; a.ph_hi = p + 1; void* args[] = {&a};
        hipError_t e = hipLaunchCooperativeKernel((const void*)fwd_kernel, dim3(grid), dim3(NWAVES * 64), args, LDS_BYTES, stream);
        if (e != hipSuccess) { fprintf(stderr, "launch failed: %s\n", hipGetErrorString(e)); break; } }
#else
    a.ph_lo = 0; a.ph_hi = 10;
    void* args[] = {&a};
    hipError_t e = hipLaunchCooperativeKernel((const void*)fwd_kernel, dim3(grid), dim3(NWAVES * 64), args, LDS_BYTES, stream);
    if (e != hipSuccess) fprintf(stderr, "cooperative launch failed: %s (grid %d)\n", hipGetErrorString(e), grid);
#endif
}
```

```cpp
#include <hip/hip_runtime.h>
#include <hip/hip_cooperative_groups.h>
#include <cstdio>
#include <cstdint>
namespace cg = cooperative_groups;
namespace pg8 {
#define PG8_LAS __attribute__((address_space(3)))
typedef unsigned short bf16_t;
typedef short bf16x8 __attribute__((ext_vector_type(8)));
typedef float f32x4 __attribute__((ext_vector_type(4)));
typedef unsigned u32x4 __attribute__((ext_vector_type(4)));
constexpr int BM = 256, BK = 64, HALF = 128, HTB = HALF * BK * 2  , STAGE_BYTES = 8 * HTB, NXCD = 8, WGM = 8;

__host__ __device__ __forceinline__ int lds_byte(int r, int c) { const int st = (r >> 4) * 2 + (c >> 5), rr = r & 15, cc = c & 31, ob = rr * 64 + cc * 2; return st * 1024 + (ob ^ (((ob >> 9) & 1) << 5)); }
__host__ __device__ __forceinline__ void stage_rc(int b, int& R, int& C) { const int st = b / 1024, sb = b % 1024, swz = sb ^ (((sb >> 9) & 1) << 5); R = (st >> 1) * 16 + swz / 64; C = (st & 1) * 32 + (swz % 64) / 2; }
__host__ __device__ __forceinline__ int perm32(int rho) { const int n = rho >> 4, i = rho & 15; return 8 * (i >> 2) + 4 * n + (i & 3); }

struct Unit { int pm, pn; };
struct Gemm { const bf16_t* A; const bf16_t* Bt; int M, N, K; };

struct StaticOrder {
    int nM, nN, nwg, G, c;
    __host__ __device__ void init(int M, int N, int G_, int c_) { nM = M / BM; nN = N / BM; nwg = nM * nN; G = G_; c = c_; }
    __host__ __device__ bool next(int i, Unit& u) const {
        const long L = (long)i * G + c; if (L >= nwg) return false;
        int wgid = (int)L; { const int q = nwg / NXCD, r = nwg % NXCD, xcd = wgid % NXCD, off = wgid / NXCD; wgid = (xcd < r ? xcd * (q + 1) : r * (q + 1) + (xcd - r) * q) + off; }
        const int nig = WGM * nN, gid = wgid / nig, fm = gid * WGM, gsz = (nM - fm) < WGM ? (nM - fm) : WGM;
        u.pm = fm + ((wgid % nig) % gsz); u.pn = (wgid % nig) / gsz; return true;
    }
    __device__ __forceinline__ void a_ready(const Unit&) const {}
    __device__ __forceinline__ void done(const Unit&) const {}
};

__device__ __forceinline__ unsigned cvt_pk_bf16(float lo, float hi) { unsigned r; asm volatile("v_cvt_pk_bf16_f32 %0, %1, %2" : "=v"(r) : "v"(lo), "v"(hi)); return r; }
template <class Epi, class Sched, bool ALIGN_EPI = false, bool SP2 = false>
__device__ __forceinline__ void gemm_phase(PG8_LAS unsigned char* lds, const Gemm g, const Sched& S, const Epi& E) {
    const int tid = threadIdx.x, wid = __builtin_amdgcn_readfirstlane(tid >> 6), lane = tid & 63, wr = wid >> 2, wc = wid & 3, fr = lane & 15, fq = lane >> 4;
    const int K = g.K, nt = K / BK;
    unsigned voffA[2], voffB[2];
#pragma unroll
    for (int i = 0; i < 2; ++i) { int R, C; stage_rc(tid * 16 + i * 8192, R, C); const int Rb = Epi::PERM ? ((R & ~31) + perm32(R & 31)) : R;
        voffA[i] = (unsigned)(R * K + C) * 2u; voffB[i] = (unsigned)(Rb * K + C) * 2u; }
    const size_t kstep = (size_t)(BK * 2);
    const size_t hstep = (size_t)HALF * K * 2;
    const size_t tstep = 2 * hstep;
    const unsigned ldsw = (unsigned)wid * 1024u;
    const int aoff = lds_byte(wr * 64 + fr, fq * 8), boff = lds_byte(wc * 32 + fr, fq * 8);
#define PG8_SA(b, h) (((b) * 2 + (h)) * HTB)
#define PG8_SB(b, h) ((4 + (b) * 2 + (h)) * HTB)
#define PG8_STAGE(bufoff, gbase, voff) do { _Pragma("unroll") for (int _i = 0; _i < 2; ++_i) \
        __builtin_amdgcn_global_load_lds((const unsigned*)((const char*)(gbase) + (voff)[_i]), (PG8_LAS unsigned*)(lds + (bufoff) + ldsw + _i * 8192), 16, 0, 0); } while (0)
#define PG8_LDA(dst, b, h) do { _Pragma("unroll") for (int m = 0; m < 4; ++m) _Pragma("unroll") for (int k = 0; k < 2; ++k) dst[m][k] = *(const PG8_LAS bf16x8*)(lds + PG8_SA(b, h) + aoff + m * 2048 + k * 1024); } while (0)
#define PG8_LDB(dst, b, h) do { _Pragma("unroll") for (int n = 0; n < 2; ++n) _Pragma("unroll") for (int k = 0; k < 2; ++k) dst[n][k] = *(const PG8_LAS bf16x8*)(lds + PG8_SB(b, h) + boff + n * 2048 + k * 1024); } while (0)
#define PG8_MMA(ai, bj, At, Bt) do { __builtin_amdgcn_s_setprio(1); _Pragma("unroll") for (int m = 0; m < 4; ++m) _Pragma("unroll") for (int n = 0; n < 2; ++n) _Pragma("unroll") for (int k = 0; k < 2; ++k) \
        acc[ai][bj][m][n] = __builtin_amdgcn_mfma_f32_16x16x32_bf16(Bt[n][k], At[m][k], acc[ai][bj][m][n], 0, 0, 0); __builtin_amdgcn_s_setprio(0); } while (0)
#define PG8_WAIT_V(n) asm volatile("s_waitcnt vmcnt(" #n ")" ::: "memory")
#define PG8_WAIT_L(n) asm volatile("s_waitcnt lgkmcnt(" #n ")" ::: "memory")
#define PG8_BAR __builtin_amdgcn_s_barrier()
#define PG8_SCHED __builtin_amdgcn_sched_barrier(0)
    Unit cur, nxt; int ui = 0;
    if (!S.next(0, cur)) return;
    f32x4 acc[2][2][4][2];
#pragma unroll
    for (int a = 0; a < 2; ++a)
#pragma unroll
        for (int b = 0; b < 2; ++b)
#pragma unroll
            for (int m = 0; m < 4; ++m)
#pragma unroll
                for (int n = 0; n < 2; ++n) acc[a][b][m][n] = (f32x4){0.f, 0.f, 0.f, 0.f};
    bf16x8 At[4][2], B0[2][2], B1[2][2];
    const char* cA = (const char*)g.A + (size_t)cur.pm * tstep; const char* cB = (const char*)g.Bt + (size_t)cur.pn * tstep;
    S.a_ready(cur);
    if constexpr (SP2) {
        PG8_STAGE(PG8_SB(0, 0), cB, voffB); PG8_STAGE(PG8_SB(0, 1), cB + hstep, voffB); PG8_STAGE(PG8_SA(0, 0), cA, voffA); PG8_STAGE(PG8_SA(0, 1), cA + hstep, voffA);
        if (wr == 1) PG8_BAR;
        PG8_WAIT_V(2); PG8_BAR;
        PG8_STAGE(PG8_SB(1, 0), cB + kstep, voffB); PG8_STAGE(PG8_SA(1, 0), cA + kstep, voffA); PG8_STAGE(PG8_SB(1, 1), cB + hstep + kstep, voffB);
        PG8_WAIT_V(6); PG8_BAR;
    } else {
        PG8_STAGE(PG8_SB(0, 0), cB, voffB); PG8_STAGE(PG8_SA(0, 0), cA, voffA); PG8_STAGE(PG8_SB(0, 1), cB + hstep, voffB); PG8_STAGE(PG8_SA(0, 1), cA + hstep, voffA);
        if (wr == 1) PG8_BAR;
        PG8_WAIT_V(4); PG8_BAR;
        PG8_STAGE(PG8_SB(1, 0), cB + kstep, voffB); PG8_STAGE(PG8_SA(1, 0), cA + kstep, voffA); PG8_STAGE(PG8_SB(1, 1), cB + hstep + kstep, voffB);
        PG8_WAIT_V(6); PG8_BAR;
    }
    for (;;) {
        const bool has_next = S.next(ui + 1, nxt);
        const char* nA = has_next ? (const char*)g.A + (size_t)nxt.pm * tstep : cA; const char* nB = has_next ? (const char*)g.Bt + (size_t)nxt.pn * tstep : cB;
        for (int t = 0; t < nt; t += 2) {
            const bool last = (t == nt - 2);
            const char* a1 = cA + (size_t)(t + 1) * kstep;
            const char* a2 = last ? nA : cA + (size_t)(t + 2) * kstep; const char* b2 = last ? nB : cB + (size_t)(t + 2) * kstep;
            const char* a3 = a2 + kstep; const char* b3 = b2 + kstep;
            if (last && has_next) S.a_ready(nxt);
            if constexpr (SP2) {
            PG8_LDB(B0, 0, 0); PG8_LDB(B1, 0, 1); PG8_SCHED; PG8_LDA(At, 0, 0); PG8_STAGE(PG8_SA(1, 1), a1 + hstep, voffA);
            PG8_WAIT_V(8); PG8_WAIT_L(0); PG8_BAR; PG8_MMA(0, 0, At, B0); PG8_MMA(0, 1, At, B1); PG8_BAR; PG8_SCHED;
            PG8_LDA(At, 0, 1); PG8_STAGE(PG8_SB(0, 0), b2, voffB); PG8_STAGE(PG8_SB(0, 1), b2 + hstep, voffB); PG8_STAGE(PG8_SA(0, 0), a2, voffA);
            PG8_WAIT_V(8); PG8_WAIT_L(0); PG8_BAR; PG8_MMA(1, 0, At, B0); PG8_MMA(1, 1, At, B1); PG8_BAR; PG8_SCHED;
            PG8_LDB(B0, 1, 0); PG8_LDB(B1, 1, 1); PG8_SCHED; PG8_LDA(At, 1, 0); PG8_STAGE(PG8_SA(0, 1), a2 + hstep, voffA);
            PG8_WAIT_V(8); PG8_WAIT_L(0); PG8_BAR; PG8_MMA(0, 0, At, B0); PG8_MMA(0, 1, At, B1); PG8_BAR; PG8_SCHED;
            PG8_LDA(At, 1, 1); PG8_STAGE(PG8_SB(1, 0), b3, voffB); PG8_STAGE(PG8_SB(1, 1), b3 + hstep, voffB); PG8_STAGE(PG8_SA(1, 0), a3, voffA);
            PG8_WAIT_V(8); PG8_WAIT_L(0); PG8_BAR; PG8_MMA(1, 0, At, B0); PG8_MMA(1, 1, At, B1); PG8_BAR; PG8_SCHED;
            } else {
            PG8_LDB(B0, 0, 0); PG8_SCHED; PG8_LDA(At, 0, 0); PG8_STAGE(PG8_SA(1, 1), a1 + hstep, voffA);
            PG8_WAIT_L(8); PG8_BAR; PG8_WAIT_L(0); PG8_MMA(0, 0, At, B0); PG8_BAR; PG8_SCHED;
            PG8_LDB(B1, 0, 1); PG8_STAGE(PG8_SB(0, 0), b2, voffB);
            PG8_BAR; PG8_WAIT_L(0); PG8_MMA(0, 1, At, B1); PG8_BAR;
            PG8_LDA(At, 0, 1); PG8_STAGE(PG8_SA(0, 0), a2, voffA);
            PG8_BAR; PG8_WAIT_L(0); PG8_MMA(1, 0, At, B0); PG8_BAR; PG8_SCHED;
            PG8_STAGE(PG8_SB(0, 1), b2 + hstep, voffB);
            PG8_WAIT_V(6); PG8_BAR; PG8_MMA(1, 1, At, B1); PG8_BAR;
            PG8_LDB(B0, 1, 0); PG8_SCHED; PG8_LDA(At, 1, 0); PG8_STAGE(PG8_SA(0, 1), a2 + hstep, voffA);
            PG8_WAIT_L(8); PG8_BAR; PG8_WAIT_L(0); PG8_MMA(0, 0, At, B0); PG8_BAR; PG8_SCHED;
            PG8_LDB(B1, 1, 1); PG8_STAGE(PG8_SB(1, 0), b3, voffB);
            PG8_BAR; PG8_WAIT_L(0); PG8_MMA(0, 1, At, B1); PG8_BAR;
            PG8_LDA(At, 1, 1); PG8_STAGE(PG8_SA(1, 0), a3, voffA);
            PG8_BAR; PG8_WAIT_L(0); PG8_MMA(1, 0, At, B0); PG8_BAR; PG8_SCHED;
            PG8_STAGE(PG8_SB(1, 1), b3 + hstep, voffB);
            PG8_WAIT_V(6); PG8_BAR; PG8_MMA(1, 1, At, B1); PG8_BAR;
            }
        }
        if constexpr (ALIGN_EPI) { if (wr == 0) PG8_BAR; }
        if constexpr (!Epi::AFTER_DRAIN) { E(acc, cur, wr, wc, fr, fq); S.done(cur); }
        if (!has_next) break;
#pragma unroll
        for (int a = 0; a < 2; ++a)
#pragma unroll
            for (int b = 0; b < 2; ++b)
#pragma unroll
                for (int m = 0; m < 4; ++m)
#pragma unroll
                    for (int n = 0; n < 2; ++n) acc[a][b][m][n] = (f32x4){0.f, 0.f, 0.f, 0.f};
        cur = nxt; cA = nA; cB = nB; ++ui;
        if constexpr (ALIGN_EPI) { if (wr == 1) PG8_BAR; }
    }
    PG8_WAIT_V(0);
    if constexpr (!ALIGN_EPI) { if (wr == 0) PG8_BAR; }
    PG8_BAR;
    if constexpr (Epi::AFTER_DRAIN) { E.fused(acc, cur, wr, wc, fr, fq, lds, wid, lane); S.done(cur); }
#undef PG8_SA
#undef PG8_SB
#undef PG8_STAGE
#undef PG8_LDA
#undef PG8_LDB
#undef PG8_MMA
#undef PG8_WAIT_V
#undef PG8_WAIT_L
#undef PG8_BAR
#undef PG8_SCHED
}
}
#ifndef PG8_SP2
#define PG8_SP2 true
#endif
#ifndef PG8_ALIGN
#define PG8_ALIGN true
#endif

constexpr int NB = 32, SEQ = 2048, DM = 1024, CTXL = 256;
constexpr int NLAT = NB * SEQ;
constexpr int NCTX = NB * CTXL;
constexpr int MTOT = NLAT + NCTX;
constexpr int NA = 4096, NBW = 2560;
constexpr float QSCALE = 0.125f * 1.4426950408889634f;
constexpr float LOG2E = 1.4426950408889634f;

#define LAS __attribute__((address_space(3)))
typedef unsigned short bf16;
typedef short bf16x8 __attribute__((ext_vector_type(8)));
typedef short s16x4 __attribute__((ext_vector_type(4)));
typedef float f32x4 __attribute__((ext_vector_type(4)));
typedef float f32x16 __attribute__((ext_vector_type(16)));
typedef unsigned u32x4 __attribute__((ext_vector_type(4)));
typedef unsigned u32x2 __attribute__((ext_vector_type(2)));
typedef float f32x2_t __attribute__((ext_vector_type(2)));
typedef __bf16 bf16x2_t __attribute__((ext_vector_type(2)));

constexpr size_t MiB = 1u << 20;
constexpr size_t WS_PAR = 0;
constexpr size_t WS_COS = 4096, WS_SIN = WS_COS + 2048 * 32 * 4;
constexpr size_t WS_MODX = 1 * MiB;
constexpr size_t WS_MODC = 2 * MiB;
constexpr size_t WS_WA = 4 * MiB;
constexpr size_t WS_WB = 12 * MiB;
constexpr size_t WS_WO = 18 * MiB;
constexpr size_t WS_CTX1 = 32 * MiB;
constexpr size_t WS_H = 64 * MiB;
constexpr size_t WS_AO = 208 * MiB;
constexpr size_t WS_QKV = 352 * MiB;
constexpr size_t WS_END = 928 * MiB;

constexpr int LDS_BYTES = 147456;
constexpr int NWAVES = 8;

__device__ __forceinline__ unsigned f2bf(float f) { unsigned u = __builtin_bit_cast(unsigned, f); return (u + 0x7fffu + ((u >> 16) & 1u)) >> 16; }
__device__ __forceinline__ unsigned pk2(float lo, float hi) { f32x2_t v = {lo, hi}; bf16x2_t b = __builtin_convertvector(v, bf16x2_t); return __builtin_bit_cast(unsigned, b); }
__device__ __forceinline__ float bf2f(unsigned short h) { return __builtin_bit_cast(float, (unsigned)h << 16); }
__device__ __forceinline__ float wave_sum(float v) {
#pragma unroll
    for (int o = 1; o < 64; o <<= 1) v += __shfl_xor(v, o);
    return v;
}
__device__ __forceinline__ float fast_exp2(float x) { return __builtin_amdgcn_exp2f(x); }
__device__ __forceinline__ float silu_f(float g) { return g * __builtin_amdgcn_rcpf(1.0f + fast_exp2(-g * LOG2E)); }

struct EpiIn {
    static constexpr bool PERM = true, AFTER_DRAIN = false;
    bf16* O; int ldc; int row_off, col_off; int rope_end, q_end, n_lat; const float* cosT; const float* sinT;
    __device__ __forceinline__ void operator()(const pg8::f32x4 (&acc)[2][2][4][2], const pg8::Unit& u, int wr, int wc, int fr, int fq) const {
        const int colt = col_off + u.pn * 256;
        const bool rope = colt < rope_end;
        const float sc = colt < q_end ? QSCALE : 1.0f;
        const int row0 = row_off + u.pm * 256 + wr * 64 + fr;
        const int col0 = colt + wc * 32 + 8 * fq;
        const bool lat = (row_off + u.pm * 256) < n_lat;
        const float sgn = fq < 2 ? -1.0f : 1.0f;
        const int tabc = (wc & 1) * 16 + 8 * (fq & 1);
#pragma unroll
        for (int ai = 0; ai < 2; ++ai)
#pragma unroll
            for (int m = 0; m < 4; ++m) {
                const int row = row0 + ai * 128 + m * 16;
                bf16* rowp = O + (size_t)row * ldc + col0;
                f32x4 c0 = {1.f, 1.f, 1.f, 1.f}, c1 = c0, s0 = {0.f, 0.f, 0.f, 0.f}, s1 = s0;
                const bool dorope = rope && lat;
                if (dorope) {
                    const int t = row & (SEQ - 1);
                    c0 = *(const f32x4*)(cosT + t * 32 + tabc); c1 = *(const f32x4*)(cosT + t * 32 + tabc + 4);
                    s0 = *(const f32x4*)(sinT + t * 32 + tabc) * sgn; s1 = *(const f32x4*)(sinT + t * 32 + tabc + 4) * sgn;
                }
#pragma unroll
                for (int bj = 0; bj < 2; ++bj) {
                    f32x4 v0 = acc[ai][bj][m][0], v1 = acc[ai][bj][m][1];
                    if (dorope) {
                        f32x4 p0, p1;
#pragma unroll
                        for (int e = 0; e < 4; ++e) { p0[e] = __shfl_xor(v0[e], 32); p1[e] = __shfl_xor(v1[e], 32); }
                        v0 = v0 * c0 + p0 * s0; v1 = v1 * c1 + p1 * s1;
                    }
                    v0 = v0 * sc; v1 = v1 * sc;
                    u32x4 w; w.x = pk2(v0[0], v0[1]); w.y = pk2(v0[2], v0[3]); w.z = pk2(v1[0], v1[1]); w.w = pk2(v1[2], v1[3]);
                    *(u32x4*)(rowp + bj * 128) = w;
                }
            }
    }
};
struct EpiOut {
    static constexpr bool PERM = false, AFTER_DRAIN = false;
    const float* base_lat; const float* base_ctx; float* out_lat; float* out_ctx; const float* gate_lat; const float* gate_ctx; int n_lat;
    __device__ __forceinline__ void operator()(const pg8::f32x4 (&acc)[2][2][4][2], const pg8::Unit& u, int wr, int wc, int fr, int fq) const {
        const int rowt = u.pm * 256;
        const bool lat = rowt < n_lat;
        const float* g = lat ? gate_lat + (size_t)(rowt >> 11) * 3072 : gate_ctx;
        const float* bs = lat ? base_lat + (size_t)rowt * DM : base_ctx + (size_t)(rowt - n_lat) * DM;
        float* op = lat ? out_lat + (size_t)rowt * DM : out_ctx + (size_t)(rowt - n_lat) * DM;
        const int col0 = u.pn * 256 + wc * 32 + 4 * fq;
        f32x4 gv[2][2];
#pragma unroll
        for (int bj = 0; bj < 2; ++bj)
#pragma unroll
            for (int n = 0; n < 2; ++n) gv[bj][n] = *(const f32x4*)(g + col0 + bj * 128 + n * 16);
#pragma unroll
        for (int ai = 0; ai < 2; ++ai)
#pragma unroll
            for (int m = 0; m < 4; ++m) {
                const size_t off = (size_t)(wr * 64 + fr + ai * 128 + m * 16) * DM + col0;
#pragma unroll
                for (int bj = 0; bj < 2; ++bj)
#pragma unroll
                    for (int n = 0; n < 2; ++n) {
                        const f32x4 b4 = *(const f32x4*)(bs + off + bj * 128 + n * 16);
                        *(f32x4*)(op + off + bj * 128 + n * 16) = b4 + gv[bj][n] * acc[ai][bj][m][n];
                    }
            }
    }
};

__device__ __forceinline__ unsigned off_b(unsigned row, unsigned ch) { return 256u * row + 16u * (ch ^ (((row & 3u) << 2) | ((row >> 2) & 3u))); }
__device__ __forceinline__ int crow(int r, int hi) { return (r & 3) + 8 * (r >> 2) + 4 * hi; }
__device__ __forceinline__ s16x4 tr_read(const LAS unsigned char* p) { return __builtin_bit_cast(s16x4, __builtin_amdgcn_ds_read_tr16_b64_v4i16((LAS s16x4*)p)); }

__device__ __forceinline__ void qk_tile(f32x16& s0, f32x16& s1, const LAS unsigned char* img, const unsigned (&koff)[4], const bf16x8 (&qf)[4]) {
    s0 = f32x16{}; s1 = f32x16{};
#pragma unroll
    for (int d0 = 0; d0 < 4; ++d0) {
        const bf16x8 a0 = *(const LAS bf16x8*)(img + koff[d0]);
        const bf16x8 a1 = *(const LAS bf16x8*)(img + koff[d0] + 8192);
        s0 = __builtin_amdgcn_mfma_f32_32x32x16_bf16(a0, qf[d0], s0, 0, 0, 0);
        s1 = __builtin_amdgcn_mfma_f32_32x32x16_bf16(a1, qf[d0], s1, 0, 0, 0);
    }
}
__device__ __forceinline__ float softmax_tile(f32x16& s0, f32x16& s1, float& m, float& l, bf16x8 (&pw)[4]) {
    float tmax = fmaxf(s0[0], s1[0]);
#pragma unroll
    for (int r = 1; r < 16; ++r) tmax = fmaxf(tmax, fmaxf(s0[r], s1[r]));
    tmax = fmaxf(tmax, __shfl_xor(tmax, 32));
    const float mnew = fmaxf(m, tmax);
    const float alpha = fast_exp2(m - mnew);
    m = mnew;
    float ps = 0.f;
#pragma unroll
    for (int r = 0; r < 16; ++r) { s0[r] = fast_exp2(s0[r] - mnew); s1[r] = fast_exp2(s1[r] - mnew); ps += s0[r] + s1[r]; }
    l = l * alpha + ps;
#pragma unroll
    for (int c = 0; c < 4; ++c) {
        u32x4 w;
        if (c < 2) { const int b = 8 * (c & 1); w.x = pk2(s0[b], s0[b + 1]); w.y = pk2(s0[b + 2], s0[b + 3]); w.z = pk2(s0[b + 4], s0[b + 5]); w.w = pk2(s0[b + 6], s0[b + 7]); }
        else       { const int b = 8 * (c & 1); w.x = pk2(s1[b], s1[b + 1]); w.y = pk2(s1[b + 2], s1[b + 3]); w.z = pk2(s1[b + 4], s1[b + 5]); w.w = pk2(s1[b + 6], s1[b + 7]); }
        pw[c] = __builtin_bit_cast(bf16x8, w);
    }
    return alpha;
}
template <int NDB>
__device__ __forceinline__ void pv_tile(f32x16 (&o)[NDB], const LAS unsigned char* vimg, const unsigned (&vb)[2][NDB], const bf16x8 (&pw)[4]) {
#pragma unroll
    for (int db = 0; db < NDB; ++db)
#pragma unroll
        for (int c = 0; c < 4; ++c) {
            const s16x4 lo = tr_read(vimg + vb[0][db] + 4096 * c);
            const s16x4 hi = tr_read(vimg + vb[1][db] + 4096 * c);
            const bf16x8 a = (bf16x8){lo[0], lo[1], lo[2], lo[3], hi[0], hi[1], hi[2], hi[3]};
            o[db] = __builtin_amdgcn_mfma_f32_32x32x16_bf16(a, pw[c], o[db], 0, 0, 0);
            if (c == 3) __builtin_amdgcn_sched_barrier(0);
        }
}
template <int NDB>
__device__ __forceinline__ void make_vb(unsigned (&vb)[2][NDB], int lane, int chbase) {
    const unsigned hi = lane >> 5, blk = (lane >> 4) & 1, q4 = (lane & 15) >> 2, p = lane & 3;
#pragma unroll
    for (int t = 0; t < 2; ++t)
#pragma unroll
        for (int db = 0; db < NDB; ++db)
            vb[t][db] = off_b(8 * t + 4 * hi + q4, chbase + 4 * db + 2 * blk + (p >> 1)) + 8 * (p & 1);
}

template <int VAR>
__device__ __forceinline__ void diff_attn_unit(LAS unsigned char* lds, const bf16* __restrict__ QKV, bf16* __restrict__ AO, int rowq0, int ctx_row0, int lat_row0, int T_in, int h,
                                               float lam, const float* __restrict__ subln_g) {
    int T = T_in; asm volatile("" : "+s"(T));
    const int tid = threadIdx.x, lane = tid & 63, wid = __builtin_amdgcn_readfirstlane(tid >> 6), r32 = lane & 31, hi = lane >> 5;
    const int map = wid >> 2, qg = wid & 3;
    const int qrow = rowq0 + qg * 32 + r32;
    bf16x8 qf[4];
    {
        const bf16* qp = QKV + (size_t)qrow * NA + h * 128 + map * 64 + hi * 8;
#pragma unroll
        for (int d0 = 0; d0 < 4; ++d0) qf[d0] = *(const bf16x8*)(qp + d0 * 16);
    }
    unsigned koff[4];
    {
        const unsigned kx = ((r32 & 3) << 2) | ((r32 >> 2) & 3);
#pragma unroll
        for (int d0 = 0; d0 < 4; ++d0) koff[d0] = 256u * r32 + 16u * ((unsigned)(8 * map + 2 * d0 + hi) ^ kx);
    }
    unsigned vb[2][4]; make_vb<4>(vb, lane, 0);
    const int srow = tid >> 4, sch = tid & 15;
    const unsigned sdst0 = off_b(srow, sch), sdst1 = off_b(srow + 32, sch);
    const bf16* kcol = QKV + 1024 + h * 128 + sch * 8;
    const bf16* vcol = QKV + 2048 + h * 128 + sch * 8;
    u32x4 kr0, kr1, vr0, vr1;
#define DA_LOAD(t) do { const size_t kr_ = (size_t)(((t) < 4 ? ctx_row0 + (t) * 64 : lat_row0 + ((t) - 4) * 64) + srow) * NA; \
        kr0 = *(const u32x4*)(kcol + kr_); kr1 = *(const u32x4*)(kcol + kr_ + (size_t)32 * NA); vr0 = *(const u32x4*)(vcol + kr_); vr1 = *(const u32x4*)(vcol + kr_ + (size_t)32 * NA); } while (0)
#define DA_STORE(st) do { LAS unsigned char* b_ = lds + (st) * 32768; *(LAS u32x4*)(b_ + sdst0) = kr0; *(LAS u32x4*)(b_ + sdst1) = kr1; \
        *(LAS u32x4*)(b_ + 16384 + sdst0) = vr0; *(LAS u32x4*)(b_ + 16384 + sdst1) = vr1; } while (0)
    f32x16 o[4]; o[0] = f32x16{}; o[1] = f32x16{}; o[2] = f32x16{}; o[3] = f32x16{};
    float m = -1e30f, l = 0.f;
    bf16x8 pw[4];
#define DA_BAR() do { asm volatile("s_waitcnt lgkmcnt(0)" ::: "memory"); __builtin_amdgcn_s_barrier(); asm volatile("" ::: "memory"); } while (0)
#define DA_STEP_A(img) do { f32x16 s0, s1; qk_tile(s0, s1, (img), koff, qf); const float alpha = softmax_tile(s0, s1, m, l, pw); \
        if (__any(alpha != 1.0f)) { o[0] = o[0] * alpha; o[1] = o[1] * alpha; o[2] = o[2] * alpha; o[3] = o[3] * alpha; } } while (0)
#define DA_FEED(t) do { if ((t) + 1 < T) { DA_STORE(((t) + 1) & 1); if ((t) + 2 < T) DA_LOAD((t) + 2); } } while (0)
    LAS float* X = (LAS float*)(lds + 65536 + qg * 17408);
    DA_LOAD(0); DA_STORE(0); if (T > 1) DA_LOAD(1);
    DA_BAR();
    if (map == 0) {
        for (int t = 0; t < T; ++t) {
            const LAS unsigned char* img = lds + (t & 1) * 32768;
            DA_STEP_A(img);
            DA_BAR();
            DA_FEED(t);
            pv_tile<4>(o, img + 16384, vb, pw);
            DA_BAR();
        }
        l += __shfl_xor(l, 32);
        DA_BAR();
    } else {
        DA_BAR();
        for (int t = 0; t < T; ++t) {
            const LAS unsigned char* img = lds + (t & 1) * 32768;
            DA_FEED(t);
            DA_STEP_A(img);
            DA_BAR();
            pv_tile<4>(o, img + 16384, vb, pw);
            if (t == T - 1) {
                l += __shfl_xor(l, 32);
                const float inv = lam / l;
#pragma unroll
                for (int db = 0; db < 4; ++db)
#pragma unroll
                    for (int r = 0; r < 16; ++r) X[(db * 16 + r) * 64 + lane] = o[db][r] * inv;
            }
            DA_BAR();
        }
    }
#undef DA_LOAD
#undef DA_STORE
#undef DA_BAR
#undef DA_STEP_A
#undef DA_FEED
    if (map == 0) {
        const float inv = 1.0f / l;
        float ss = 0.f;
#pragma unroll
        for (int db = 0; db < 4; ++db)
#pragma unroll
            for (int r = 0; r < 16; ++r) { const float v = o[db][r] * inv - X[(db * 16 + r) * 64 + lane]; o[db][r] = v; ss += v * v; }
        ss += __shfl_xor(ss, 32);
        const float rstd = __builtin_amdgcn_rsqf(ss * (1.0f / 128.0f) + 1e-5f) * 0.8f;
        asm volatile("s_waitcnt lgkmcnt(0)" ::: "memory");
#pragma unroll
        for (int db = 0; db < 4; ++db)
#pragma unroll
            for (int k = 0; k < 4; ++k) {
                f32x4 y; y[0] = o[db][4 * k] * rstd; y[1] = o[db][4 * k + 1] * rstd; y[2] = o[db][4 * k + 2] * rstd; y[3] = o[db][4 * k + 3] * rstd;
                *(LAS f32x4*)(X + r32 * 132 + 32 * db + 8 * k + 4 * hi) = y;
            }
        asm volatile("s_waitcnt lgkmcnt(0)" ::: "memory");
        const int dc = 8 * (lane & 15);
        const f32x4 sg0 = *(const f32x4*)(subln_g + dc), sg1 = *(const f32x4*)(subln_g + dc + 4);
        const int rbase = rowq0 + qg * 32;
#pragma unroll 2
        for (int i = 0; i < 8; ++i) {
            const int rr = 4 * i + (lane >> 4);
            const f32x4 y0 = *(const LAS f32x4*)(X + rr * 132 + dc), y1 = *(const LAS f32x4*)(X + rr * 132 + dc + 4);
            const u32x4 g4 = *(const u32x4*)(QKV + (size_t)(rbase + rr) * NA + 3072 + h * 128 + dc);
            float gf[8];
            gf[0] = __builtin_bit_cast(float, g4.x << 16); gf[1] = __builtin_bit_cast(float, g4.x & 0xffff0000u);
            gf[2] = __builtin_bit_cast(float, g4.y << 16); gf[3] = __builtin_bit_cast(float, g4.y & 0xffff0000u);
            gf[4] = __builtin_bit_cast(float, g4.z << 16); gf[5] = __builtin_bit_cast(float, g4.z & 0xffff0000u);
            gf[6] = __builtin_bit_cast(float, g4.w << 16); gf[7] = __builtin_bit_cast(float, g4.w & 0xffff0000u);
            u32x4 w;
            w.x = pk2(y0[0] * sg0[0] * silu_f(gf[0]), y0[1] * sg0[1] * silu_f(gf[1]));
            w.y = pk2(y0[2] * sg0[2] * silu_f(gf[2]), y0[3] * sg0[3] * silu_f(gf[3]));
            w.z = pk2(y1[0] * sg1[0] * silu_f(gf[4]), y1[1] * sg1[1] * silu_f(gf[5]));
            w.w = pk2(y1[2] * sg1[2] * silu_f(gf[6]), y1[3] * sg1[3] * silu_f(gf[7]));
            *(u32x4*)(AO + (size_t)(rbase + rr) * DM + h * 128 + dc) = w;
        }
    }
}

__device__ __forceinline__ void win_attn_unit(LAS unsigned char* lds, const bf16* __restrict__ QKV, bf16* __restrict__ AO, int b, int kvh, int qb, const float* __restrict__ sink) {
    const int tid = threadIdx.x, lane = tid & 63, wid = __builtin_amdgcn_readfirstlane(tid >> 6), r32 = lane & 31, hi = lane >> 5;
    const int g = wid & 3, rg = wid >> 2, head = kvh * 4 + g;
    const int qpos = qb * 64 + rg * 32 + r32;
    const int qrow = b * SEQ + qpos;
    bf16x8 qf[4];
    {
        const bf16* qp = QKV + (size_t)qrow * NBW + head * 64 + hi * 8;
#pragma unroll
        for (int d0 = 0; d0 < 4; ++d0) qf[d0] = *(const bf16x8*)(qp + d0 * 16);
    }
    unsigned koff[4];
    {
        const unsigned kx = ((r32 & 3) << 2) | ((r32 >> 2) & 3);
#pragma unroll
        for (int d0 = 0; d0 < 4; ++d0) koff[d0] = 256u * r32 + 16u * ((unsigned)(2 * d0 + hi) ^ kx);
    }
    unsigned vb[2][2]; make_vb<2>(vb, lane, 8);
    const int srow = tid >> 4, sch = tid & 15;
    const unsigned sdst0 = off_b(srow, sch), sdst1 = off_b(srow + 32, sch);
    const bf16* scol = QKV + (sch < 8 ? 1024 + kvh * 64 + sch * 8 : 1280 + kvh * 64 + (sch - 8) * 8);
    const int kt_lo = qb - 2 < 0 ? 0 : qb - 2, kt_hi = qb + 2 > 31 ? 31 : qb + 2;
    const int T = 4 + (kt_hi - kt_lo + 1);
    const int ctx_row0 = NLAT + b * CTXL, lat_row0 = b * SEQ;
    u32x4 r0, r1;
#define WA_LOAD(t) do { const size_t kr_ = (size_t)(((t) < 4 ? ctx_row0 + (t) * 64 : lat_row0 + (kt_lo + (t) - 4) * 64) + srow) * NBW; \
        r0 = *(const u32x4*)(scol + kr_); r1 = *(const u32x4*)(scol + kr_ + (size_t)32 * NBW); } while (0)
#define WA_STORE(st) do { LAS unsigned char* b_ = lds + (st) * 16384; *(LAS u32x4*)(b_ + sdst0) = r0; *(LAS u32x4*)(b_ + sdst1) = r1; } while (0)
    f32x16 o[2]; o[0] = f32x16{}; o[1] = f32x16{};
    float m = -1e30f, l = 0.f;
    WA_LOAD(0); WA_STORE(0); __syncthreads();
    for (int t = 0; t < T; ++t) {
        const bool more = t + 1 < T;
        if (more) WA_LOAD(t + 1);
        const LAS unsigned char* img = lds + (t & 1) * 16384;
        f32x16 s0, s1; bf16x8 pw[4];
        qk_tile(s0, s1, img, koff, qf);
        if (t >= 4) {
            const int kt = kt_lo + t - 4;
            if (kt == qb - 2 || kt == qb + 2) {
                const int kbase = kt * 64 - qpos;
#pragma unroll
                for (int r = 0; r < 16; ++r) {
                    const int d0_ = kbase + crow(r, hi), d1_ = d0_ + 32;
                    if (d0_ > 128 || d0_ < -128) s0[r] = -1e30f;
                    if (d1_ > 128 || d1_ < -128) s1[r] = -1e30f;
                }
            }
        }
        const float alpha = softmax_tile(s0, s1, m, l, pw);
        if (__any(alpha != 1.0f)) { o[0] = o[0] * alpha; o[1] = o[1] * alpha; }
        pv_tile<2>(o, img, vb, pw);
        if (more) WA_STORE((t + 1) & 1);
        __syncthreads();
    }
#undef WA_LOAD
#undef WA_STORE
    l += __shfl_xor(l, 32);
    l += fast_exp2(sink[head] * LOG2E - m);
    const float inv = 1.0f / l;
    const bf16* gp = QKV + (size_t)qrow * NBW + 1536 + head * 64 + 4 * hi;
    bf16* op = AO + (size_t)qrow * DM + head * 64 + 4 * hi;
#pragma unroll
    for (int db = 0; db < 2; ++db)
#pragma unroll
        for (int k = 0; k < 4; ++k) {
            const int d = 32 * db + 8 * k;
            const u32x2 g2 = *(const u32x2*)(gp + d);
            const float g0 = __builtin_bit_cast(float, g2.x << 16), g1 = __builtin_bit_cast(float, g2.x & 0xffff0000u);
            const float g2f = __builtin_bit_cast(float, g2.y << 16), g3 = __builtin_bit_cast(float, g2.y & 0xffff0000u);
            const float y0 = o[db][4 * k + 0] * inv * silu_f(g0), y1 = o[db][4 * k + 1] * inv * silu_f(g1);
            const float y2 = o[db][4 * k + 2] * inv * silu_f(g2f), y3 = o[db][4 * k + 3] * inv * silu_f(g3);
            u32x2 w; w.x = pk2(y0, y1); w.y = pk2(y2, y3);
            *(u32x2*)(op + d) = w;
        }
}

__device__ __forceinline__ void transpose_item(const float* __restrict__ W, int K, int N, bf16* __restrict__ WT, LAS float* scr, int item, int lane) {
    const int nblk = N / 32, kb = item / nblk, nb = item % nblk, k0 = 64 * kb, n0 = 32 * nb;
#pragma unroll 8
    for (int i = 0; i < 32; ++i) { const int kk = 2 * i + (lane >> 5); scr[kk * 33 + (lane & 31)] = W[(size_t)(k0 + kk) * N + n0 + (lane & 31)]; }
    asm volatile("s_waitcnt lgkmcnt(0)" ::: "memory");
    const int c = lane & 7;
#pragma unroll
    for (int j = 0; j < 4; ++j) { const int n = (lane >> 3) + 8 * j; const LAS float* s = scr + (8 * c) * 33 + n;
        u32x4 o; o.x = pk2(s[0 * 33], s[1 * 33]); o.y = pk2(s[2 * 33], s[3 * 33]); o.z = pk2(s[4 * 33], s[5 * 33]); o.w = pk2(s[6 * 33], s[7 * 33]);
        *(u32x4*)(WT + (size_t)(n0 + n) * K + k0 + 8 * c) = o; }
    asm volatile("s_waitcnt lgkmcnt(0)" ::: "memory");
}
__device__ __forceinline__ void norm_mod_pass(const float* __restrict__ xlat, const float* __restrict__ xctx, const float* __restrict__ g, const float* __restrict__ modx,
                                              const float* __restrict__ modc, bf16* __restrict__ H, int gw, int ngw, int lane) {
    for (int mrow = gw; mrow < MTOT; mrow += ngw) {
        const bool lat = mrow < NLAT;
        const float* src = lat ? xlat + (size_t)mrow * DM : xctx + (size_t)(mrow - NLAT) * DM;
        const float* mod = lat ? modx + (size_t)(mrow >> 11) * 3072 : modc;
        f32x4 v[4]; float ss = 0.f;
#pragma unroll
        for (int j = 0; j < 4; ++j) { v[j] = *(const f32x4*)(src + 4 * (lane + 64 * j)); ss += (v[j][0] * v[j][0] + v[j][1] * v[j][1]) + (v[j][2] * v[j][2] + v[j][3] * v[j][3]); }
        const float rstd = 1.0f / sqrtf(wave_sum(ss) * (1.0f / DM) + 1e-6f);
#pragma unroll
        for (int j = 0; j < 4; ++j) {
            const int col = 4 * (lane + 64 * j);
            const f32x4 gg = *(const f32x4*)(g + col), sh = *(const f32x4*)(mod + col), sc = *(const f32x4*)(mod + 1024 + col);
            const f32x4 hh = v[j] * rstd * gg * (sc + 1.0f) + sh;
            u32x2 w; w.x = pk2(hh[0], hh[1]); w.y = pk2(hh[2], hh[3]);
            *(u32x2*)(H + (size_t)mrow * DM + col) = w;
        }
    }
}
__device__ __forceinline__ void final_norm_pass(float* __restrict__ xo, const float* __restrict__ g, int gw, int ngw, int lane) {
    for (int mrow = gw; mrow < NLAT; mrow += ngw) {
        float* src = xo + (size_t)mrow * DM;
        f32x4 v[4]; float ss = 0.f;
#pragma unroll
        for (int j = 0; j < 4; ++j) { v[j] = *(const f32x4*)(src + 4 * (lane + 64 * j)); ss += (v[j][0] * v[j][0] + v[j][1] * v[j][1]) + (v[j][2] * v[j][2] + v[j][3] * v[j][3]); }
        const float rstd = 1.0f / sqrtf(wave_sum(ss) * (1.0f / DM) + 1e-6f);
#pragma unroll
        for (int j = 0; j < 4; ++j) { const int col = 4 * (lane + 64 * j); const f32x4 gg = *(const f32x4*)(g + col); *(f32x4*)(src + col) = v[j] * rstd * gg; }
    }
}

struct Args {
    const float *x, *c, *ctx, *c_ctx, *w_mod, *b_mod, *norm_g, *w_o, *a_w_in, *lq1, *lk1, *lq2, *lk2, *subln_g, *b_w_in, *b_sink, *final_g;
    float* out; unsigned char* ws; int ph_lo, ph_hi, var, pad;
};

__global__ void __launch_bounds__(NWAVES * 64, 2) fwd_kernel(Args a) {
    extern __shared__ __attribute__((aligned(16))) unsigned char lds_raw[];
    LAS unsigned char* lds = (LAS unsigned char*)lds_raw;
    cg::grid_group grid = cg::this_grid();
    const int tid = threadIdx.x, lane = tid & 63, wave = __builtin_amdgcn_readfirstlane(tid >> 6);
    const int G = gridDim.x, bx = blockIdx.x;
    const int vcu = (G % 8 == 0) ? (bx % 8) * (G / 8) + bx / 8 : bx;
    const int gw = vcu * NWAVES + wave, ngw = G * NWAVES;
    unsigned char* ws = a.ws;
    float* par = (float*)(ws + WS_PAR);
    float* cosT = (float*)(ws + WS_COS); float* sinT = (float*)(ws + WS_SIN);
    float* modx = (float*)(ws + WS_MODX); float* modc = (float*)(ws + WS_MODC);
    bf16* WA = (bf16*)(ws + WS_WA); bf16* WB = (bf16*)(ws + WS_WB); bf16* WO = (bf16*)(ws + WS_WO);
    float* CTX1 = (float*)(ws + WS_CTX1);
    bf16* H = (bf16*)(ws + WS_H); bf16* AO = (bf16*)(ws + WS_AO); bf16* QKV = (bf16*)(ws + WS_QKV);
    const int lo = a.ph_lo, hi_ph = a.ph_hi;
#ifndef PHMASK
#define PHMASK 0x3ff
#endif
#define IN(k) (((PHMASK >> (k)) & 1) && lo <= (k) && (k) < hi_ph)
#define SEAM(k) do { if (IN(k) && IN((k) + 1)) grid.sync(); } while (0)

    if (IN(0)) {
        if (bx < 96) {
            LAS float* S = (LAS float*)lds;
            for (int idx = tid; idx < 33 * 1024; idx += NWAVES * 64) { const float v = idx < 32 * 1024 ? a.c[idx] : a.c_ctx[idx - 32 * 1024]; S[idx] = silu_f(v); }
            __syncthreads();
            const int li = bx / 48, n0 = (bx % 48) * 64;
            float acc[33];
#pragma unroll
            for (int r = 0; r < 33; ++r) acc[r] = 0.f;
            const float* w = a.w_mod + (size_t)li * 1024 * 3072 + n0 + lane;
            for (int kk = 0; kk < 128; kk += 4) {
                const int k = wave * 128 + kk;
                const float w0 = w[(size_t)k * 3072], w1 = w[(size_t)(k + 1) * 3072], w2 = w[(size_t)(k + 2) * 3072], w3 = w[(size_t)(k + 3) * 3072];
#pragma unroll
                for (int r = 0; r < 33; ++r) { const f32x4 s = *(const LAS f32x4*)(S + r * 1024 + k); acc[r] += (s[0] * w0 + s[1] * w1) + (s[2] * w2 + s[3] * w3); }
            }
            __syncthreads();
            LAS float* red = (LAS float*)lds;
#pragma unroll
            for (int r = 0; r < 33; ++r) red[(wave * 33 + r) * 64 + lane] = acc[r];
            __syncthreads();
            for (int idx = tid; idx < 33 * 64; idx += NWAVES * 64) {
                const int r = idx >> 6, l = idx & 63; float s = 0.f;
#pragma unroll
                for (int w8 = 0; w8 < 8; ++w8) s += red[(w8 * 33 + r) * 64 + l];
                s += a.b_mod[li * 3072 + n0 + l];
                if (r < 32) modx[(size_t)(li * 32 + r) * 3072 + n0 + l] = s; else modc[li * 3072 + n0 + l] = s;
            }
            __syncthreads();
        }
        {
            LAS float* scr = (LAS float*)(lds + wave * 16384);
            constexpr int I_A = 16 * (NA / 32), I_B = 16 * (NBW / 32), I_O = 16 * (DM / 32);
            constexpr int NITEMS = I_A + I_B + 2 * I_O;
            for (int it = gw; it < NITEMS; it += ngw) {
                int r = it;
                if (r < I_A) { transpose_item(a.a_w_in, DM, NA, WA, scr, r, lane); continue; } r -= I_A;
                if (r < I_B) { transpose_item(a.b_w_in, DM, NBW, WB, scr, r, lane); continue; } r -= I_B;
                if (r < I_O) { transpose_item(a.w_o, DM, DM, WO, scr, r, lane); continue; } r -= I_O;
                transpose_item(a.w_o + (size_t)DM * DM, DM, DM, WO + (size_t)DM * DM, scr, r, lane);
            }
        }
        for (int idx = gw * 64 + lane; idx < 2048 * 32; idx += ngw * 64) {
            const int t = idx >> 5, j = idx & 31, i = j & 15;
            const float pos = (float)(j < 16 ? (t >> 6) : (t & 63));
            const float invf = exp2f(-(float)i * (13.287712379549449f / 16.0f));
            const float ang = pos * invf;
            cosT[idx] = __cosf(ang); sinT[idx] = __sinf(ang);
        }
        if (bx == G - 1 && wave == 0) {
            const float p1 = wave_sum(a.lq1[lane] * a.lk1[lane]), p2 = wave_sum(a.lq2[lane] * a.lk2[lane]);
            if (lane == 0) par[0] = expf(p1) - expf(p2) + 0.2f;
        }
    }
    SEAM(0);
    if (IN(1)) norm_mod_pass(a.x, a.ctx, a.norm_g, modx, modc, H, gw, ngw, lane);
    SEAM(1);
    if (IN(2)) {
        pg8::Gemm g{H, WA, MTOT, NA, DM}; pg8::StaticOrder S; S.init(MTOT, NA, G, bx);
        EpiIn E{QKV, NA, 0, 0, 2048, 1024, NLAT, cosT, sinT};
        pg8::gemm_phase<EpiIn, pg8::StaticOrder, PG8_ALIGN, PG8_SP2>(lds, g, S, E);
    }
    SEAM(2);
#define P3_BODY(VAR, DST) do { const float lam = par[0]; \
        for (int L = vcu; L < 4096; L += G) { \
            const int i = L >> 8, v = L & 255, xq = v >> 5, j = v & 31; \
            const int pair = 32 * xq + 2 * i + (j >> 4), qb = j & 15, b = pair >> 3, h = pair & 7; \
            diff_attn_unit<VAR>(lds, QKV, DST, b * SEQ + qb * 128, NLAT + b * CTXL, b * SEQ, 36, h, lam, a.subln_g); \
        } \
        for (int L = vcu; L < 512; L += G) { \
            const int pair = L >> 1, qb = L & 1, b = pair >> 3, h = pair & 7; \
            diff_attn_unit<VAR>(lds, QKV, DST, NLAT + b * CTXL + qb * 128, NLAT + b * CTXL, 0, 4, h, lam, a.subln_g); \
        } } while (0)
    if (IN(3)) {
#if defined(PROBE_VAR)
        if (a.var != 0) P3_BODY(PROBE_VAR, H); else
#endif
        P3_BODY(0, AO);
    }
    SEAM(3);
    if (IN(4)) {
        pg8::Gemm g{AO, WO, MTOT, DM, DM}; pg8::StaticOrder S; S.init(MTOT, DM, G, bx);
        EpiOut E{a.x, a.ctx, a.out, CTX1, modx + 2048, modc + 2048, NLAT};
        pg8::gemm_phase<EpiOut, pg8::StaticOrder, PG8_ALIGN, PG8_SP2>(lds, g, S, E);
    }
    SEAM(4);
    if (IN(5)) norm_mod_pass(a.out, CTX1, a.norm_g + DM, modx + 32 * 3072, modc + 3072, H, gw, ngw, lane);
    SEAM(5);
    if (IN(6)) {
        {
            pg8::Gemm g{H, WB, NLAT, NBW, DM}; pg8::StaticOrder S; S.init(NLAT, NBW, G, bx);
            EpiIn E{QKV, NBW, 0, 0, 1280, 1024, NLAT, cosT, sinT};
            pg8::gemm_phase<EpiIn, pg8::StaticOrder, PG8_ALIGN, PG8_SP2>(lds, g, S, E);
        }
        {
            pg8::Gemm g{H + (size_t)NLAT * DM, WB + (size_t)1024 * DM, NCTX, 512, DM}; pg8::StaticOrder S; S.init(NCTX, 512, G, bx);
            EpiIn E{QKV, NBW, NLAT, 1024, 1280, 1024, NLAT, cosT, sinT};
            pg8::gemm_phase<EpiIn, pg8::StaticOrder, PG8_ALIGN, PG8_SP2>(lds, g, S, E);
        }
    }
    SEAM(6);
    if (IN(7)) {
        for (int L = vcu; L < 4096; L += G) {
            const int i = L >> 8, v = L & 255, pair = v >> 1, qb = (v & 1) * 16 + i, b = pair >> 2, kvh = pair & 3;
            win_attn_unit(lds, QKV, AO, b, kvh, qb, a.b_sink);
        }
    }
    SEAM(7);
    if (IN(8)) {
        pg8::Gemm g{AO, WO + (size_t)DM * DM, NLAT, DM, DM}; pg8::StaticOrder S; S.init(NLAT, DM, G, bx);
        EpiOut E{a.out, a.out, a.out, a.out, modx + 32 * 3072 + 2048, modc + 3072 + 2048, NLAT};
        pg8::gemm_phase<EpiOut, pg8::StaticOrder, PG8_ALIGN, PG8_SP2>(lds, g, S, E);
    }
    SEAM(8);
    if (IN(9)) final_norm_pass(a.out, a.final_g, gw, ngw, lane);
#undef IN
#undef SEAM
}

#ifndef MK_PER_PHASE
#define MK_PER_PHASE 0
#endif
extern "C" void kernel_launch(void* const* d_in, const int* in_sizes, int n_in, void* d_out, int out_size, void* d_ws, size_t ws_size, hipStream_t stream) {
    static int grid = 0;
    if (grid == 0) {
        if (n_in != 17 || in_sizes[0] != NLAT * DM || out_size != NLAT * DM || ws_size < WS_END) {
            fprintf(stderr, "kernel_launch: unexpected shapes: n_in %d in0 %d out %d ws %zu\n", n_in, n_in > 0 ? in_sizes[0] : -1, out_size, ws_size); grid = -1; return; }
        int dev = 0, cus = 0, per_cu = 0;
        hipGetDevice(&dev);
        hipDeviceGetAttribute(&cus, hipDeviceAttributeMultiprocessorCount, dev);
        if (hipFuncSetAttribute((const void*)fwd_kernel, hipFuncAttributeMaxDynamicSharedMemorySize, LDS_BYTES) != hipSuccess) { fprintf(stderr, "kernel_launch: hipFuncSetAttribute failed\n"); grid = -1; return; }
        if (hipOccupancyMaxActiveBlocksPerMultiprocessor(&per_cu, (const void*)fwd_kernel, NWAVES * 64, LDS_BYTES) != hipSuccess || per_cu < 1) { fprintf(stderr, "kernel_launch: occupancy query says %d blocks per CU\n", per_cu); per_cu = 1; }
        (void)hipGetLastError();
        grid = cus * (per_cu > 1 ? 1 : per_cu);
    }
    if (grid < 0) return;
    Args a{};
    const float** f = (const float**)&a;
    for (int i = 0; i < 17; ++i) f[i] = (const float*)d_in[i];
    a.out = (float*)d_out; a.ws = (unsigned char*)d_ws;
#if defined(PROBE_VAR)
    for (int p = 0; p < 3; ++p) { a.ph_lo = p == 0 ? 0 : (p == 1 ? 3 : 4); a.ph_hi = p == 2 ? 10 : 4; a.var = (p == 1); void* args[] = {&a};
        hipError_t e = hipLaunchCooperativeKernel((const void*)fwd_kernel, dim3(grid), dim3(NWAVES * 64), args, LDS_BYTES, stream);
        if (e != hipSuccess) { fprintf(stderr, "launch failed: %s\n", hipGetErrorString(e)); break; } }
#elif defined(PROBE_DUP)
    for (int p = 0; p < 2; ++p) { a.ph_lo = p ? PROBE_DUP : 0; a.ph_hi = p ? 10 : PROBE_DUP + 1; void* args[] = {&a};
        hipError_t e = hipLaunchCooperativeKernel((const void*)fwd_kernel, dim3(grid), dim3(NWAVES * 64), args, LDS_BYTES, stream);
        if (e != hipSuccess) { fprintf(stderr, "launch failed: %s\n", hipGetErrorString(e)); break; } }
#elif MK_PER_PHASE
    for (int p = 0; p < 10; ++p) { a.ph_lo = p; a.ph_hi = p + 1; void* args[] = {&a};
        hipError_t e = hipLaunchCooperativeKernel((const void*)fwd_kernel, dim3(grid), dim3(NWAVES * 64), args, LDS_BYTES, stream);
        if (e != hipSuccess) { fprintf(stderr, "launch failed: %s\n", hipGetErrorString(e)); break; } }
#else
    a.ph_lo = 0; a.ph_hi = 10;
    void* args[] = {&a};
    hipError_t e = hipLaunchCooperativeKernel((const void*)fwd_kernel, dim3(grid), dim3(NWAVES * 64), args, LDS_BYTES, stream);
    if (e != hipSuccess) fprintf(stderr, "cooperative launch failed: %s (grid %d)\n", hipGetErrorString(e), grid);
#endif
}
```
